# Optimizing an MI355X kernel written in HIP

```python
import math
import jax, jax.numpy as jnp
from jax import lax
import numpy as np

D_MODEL = 1024
BATCH = 4
SEQ = 4096
DEPTH = 4

HEAD_DIM = 64
BLOCK = 128
A_HEADS = 8
A_KV_HEADS = 2
A_WINDOW = 128
B_HEADS = 8
B_CONFIGS = ((128, 1), (512, 4), (2048, 16))
NUM_BUCKETS = 32
MAX_DISTANCE = 2048
C_HEADS = 16
C_Q_RANK = 256
C_KV_RANK = 128
C_NOPE = 64
C_ROPE = 32
C_V = 64
ROPE_THETA = 10000.0
EPS = 1e-6

A_WIDTH = A_HEADS * HEAD_DIM
A_KV_WIDTH = A_KV_HEADS * HEAD_DIM
B_WIDTH = B_HEADS * HEAD_DIM
AB_WIDTH = A_WIDTH + B_WIDTH
AB_IN = A_WIDTH + 2 * A_KV_WIDTH + 3 * B_WIDTH + AB_WIDTH
C_WIDTH = C_HEADS * C_V
C_IN = C_Q_RANK + C_KV_RANK + C_ROPE + C_WIDTH
N_AB = (DEPTH + 1) // 2
N_C = DEPTH // 2

kernel_name = "hybrid_swa_dilated_mla_gated"


def rmsnorm(x, w):
    xf = x.astype(jnp.float32)
    y = xf * lax.rsqrt(jnp.mean(xf * xf, axis=-1, keepdims=True) + EPS)
    return (y * w.astype(jnp.float32)).astype(x.dtype)


def t5_bucket(dist):
    max_exact = NUM_BUCKETS // 2
    d = jnp.maximum(dist, 1).astype(jnp.float32)
    large = max_exact + (jnp.log(d / max_exact) / math.log(MAX_DISTANCE / max_exact)
                         * (NUM_BUCKETS - max_exact)).astype(jnp.int32)
    large = jnp.minimum(large, NUM_BUCKETS - 1)
    return jnp.where(dist < max_exact, dist, large)


def band_bias(rel_bias_h, dilation, window):
    i = jnp.arange(BLOCK)[:, None]
    j = jnp.arange(2 * BLOCK)[None, :]
    dist = i + BLOCK - j
    in_band = (dist >= 0) & (dist <= window)
    bucket = t5_bucket(jnp.maximum(dist, 0) * dilation)
    bias = jnp.transpose(rel_bias_h[bucket].astype(jnp.float32), (2, 0, 1))
    return bias, in_band


def banded_attention(q, k, v, bias, in_band, sink=None):
    n, length, hq, dh = q.shape
    hkv = k.shape[2]
    g = hq // hkv
    nb = -(-length // BLOCK)
    padw = ((0, 0), (0, nb * BLOCK - length), (0, 0), (0, 0))
    qb = jnp.pad(q, padw).reshape(n, nb, BLOCK, hkv, g, dh)
    kb = jnp.pad(k, padw).reshape(n, nb, BLOCK, hkv, dh)
    vb = jnp.pad(v, padw).reshape(n, nb, BLOCK, hkv, dh)

    def with_prev(t):
        prev = jnp.pad(t, ((0, 0), (1, 0), (0, 0), (0, 0), (0, 0)))[:, :-1]
        return jnp.concatenate([prev, t], axis=2)

    kk, vv = with_prev(kb), with_prev(vb)
    s = jnp.einsum('nbqhgd,nbkhd->nbhgqk', qb, kk).astype(jnp.float32) * (dh ** -0.5)
    s = s + bias.reshape(hkv, g, BLOCK, 2 * BLOCK)
    kpos = (jnp.arange(nb)[:, None] - 1) * BLOCK + jnp.arange(2 * BLOCK)[None, :]
    mask = in_band[None] & (kpos >= 0)[:, None, :]
    s = jnp.where(mask[None, :, None, None], s, -jnp.inf)
    m = jnp.max(s, axis=-1, keepdims=True)
    if sink is not None:
        sk = sink.astype(jnp.float32).reshape(1, 1, hkv, g, 1, 1)
        m = jnp.maximum(m, sk)
    p = jnp.exp(s - m)
    denom = jnp.sum(p, axis=-1, keepdims=True)
    if sink is not None:
        denom = denom + jnp.exp(sk - m)
    o = jnp.einsum('nbhgqk,nbkhd->nbqhgd', (p / denom).astype(v.dtype), vv)
    o = o.reshape(n, nb * BLOCK, hq, dh)[:, :length]
    lse = (m + jnp.log(denom))[..., 0]
    lse = jnp.transpose(lse, (0, 1, 4, 2, 3)).reshape(n, nb * BLOCK, hq)[:, :length]
    return o, lse


def to_strided(t, d):
    b, s = t.shape[:2]
    sp = -(-s // d) * d
    t = jnp.pad(t, ((0, 0), (0, sp - s)) + ((0, 0),) * (t.ndim - 2))
    t = jnp.moveaxis(t.reshape((b, sp // d, d) + t.shape[2:]), 2, 1)
    return t.reshape((b * d, sp // d) + t.shape[3:])


def from_strided(t, b, s, d):
    length = t.shape[1]
    t = jnp.moveaxis(t.reshape((b, d, length) + t.shape[2:]), 1, 2)
    return t.reshape((b, length * d) + t.shape[3:])[:, :s]


def swa_dilated_layer(h, w_in, sinks, w_out, rel_bias):
    b, s, _ = h.shape
    splits = list(np.cumsum([A_WIDTH, A_KV_WIDTH, A_KV_WIDTH, B_WIDTH, B_WIDTH, B_WIDTH]))
    qa, ka, va, qb, kb, vb, z = jnp.split(h @ w_in, splits, axis=-1)
    qa = qa.reshape(b, s, A_HEADS, HEAD_DIM)
    ka = ka.reshape(b, s, A_KV_HEADS, HEAD_DIM)
    va = va.reshape(b, s, A_KV_HEADS, HEAD_DIM)
    qb, kb, vb = (t.reshape(b, s, B_HEADS, HEAD_DIM) for t in (qb, kb, vb))

    bias_a, band_a = band_bias(rel_bias[:, :A_HEADS], 1, A_WINDOW)
    oa, _ = banded_attention(qa, ka, va, bias_a, band_a, sinks)

    outs, lses = [], []
    for window, dil in B_CONFIGS:
        bias_b, band_b = band_bias(rel_bias[:, A_HEADS:], dil, window // dil)
        o, lse = banded_attention(to_strided(qb, dil), to_strided(kb, dil),
                                  to_strided(vb, dil), bias_b, band_b)
        outs.append(from_strided(o, b, s, dil))
        lses.append(from_strided(lse, b, s, dil))
    wts = jax.nn.softmax(jnp.stack(lses), axis=0)
    ob = jnp.sum(wts[..., None] * jnp.stack(outs).astype(jnp.float32), axis=0).astype(h.dtype)

    o = jnp.concatenate([oa.reshape(b, s, A_WIDTH), ob.reshape(b, s, B_WIDTH)], axis=-1)
    return (o * jax.nn.silu(z)) @ w_out


def rope(t, cos, sin):
    half = t.shape[-1] // 2
    t1, t2 = t[..., :half], t[..., half:]
    return jnp.concatenate([t1 * cos - t2 * sin, t1 * sin + t2 * cos], axis=-1).astype(t.dtype)


def mla_layer(h, positions, w_in, q_norm, w_qb, kv_norm, w_kvb, w_out):
    b, s, _ = h.shape
    splits = list(np.cumsum([C_Q_RANK, C_KV_RANK, C_ROPE]))
    c_q, c_kv, k_pe, z = jnp.split(h @ w_in, splits, axis=-1)
    q = (rmsnorm(c_q, q_norm) @ w_qb).reshape(b, s, C_HEADS, C_NOPE + C_ROPE)
    q_nope, q_pe = q[..., :C_NOPE], q[..., C_NOPE:]
    kv = (rmsnorm(c_kv, kv_norm) @ w_kvb).reshape(b, s, C_HEADS, C_NOPE + C_V)
    k_nope, v = kv[..., :C_NOPE], kv[..., C_NOPE:]

    inv_freq = ROPE_THETA ** (-jnp.arange(0, C_ROPE, 2, dtype=jnp.float32) / C_ROPE)
    ang = positions.astype(jnp.float32)[..., None] * inv_freq
    cos, sin = jnp.cos(ang)[:, :, None], jnp.sin(ang)[:, :, None]
    q_pe = rope(q_pe, cos, sin)
    k_pe = rope(k_pe[:, :, None], cos, sin)[:, :, 0]

    scale = (C_NOPE + C_ROPE) ** -0.5
    nb = s // BLOCK
    kpos = jnp.arange(s)

    def to_blocks(t):
        return jnp.moveaxis(t.reshape((b, nb, BLOCK) + t.shape[2:]), 1, 0)

    def attend_block(args):
        qn, qp, blk = args
        sc = (jnp.einsum('bqhd,bkhd->bhqk', qn, k_nope)
              + jnp.einsum('bqhr,bkr->bhqk', qp, k_pe)).astype(jnp.float32) * scale
        qpos = blk * BLOCK + jnp.arange(BLOCK)
        sc = jnp.where(kpos[None, :] <= qpos[:, None], sc, -jnp.inf)
        p = jax.nn.softmax(sc, axis=-1).astype(v.dtype)
        return jnp.einsum('bhqk,bkhd->bqhd', p, v)

    o = lax.map(attend_block, (to_blocks(q_nope), to_blocks(q_pe), jnp.arange(nb)))
    o = jnp.moveaxis(o, 0, 1).reshape(b, s, C_WIDTH)
    return (o * jax.nn.silu(z)) @ w_out


def setup_inputs(seed: int = 0) -> dict:
    key = jax.random.key(seed)
    ks = jax.random.split(key, 16)
    f32 = jnp.float32

    def dense(k, shape):
        return jax.random.normal(k, shape, f32) * shape[-2] ** -0.5

    def gain(k, shape):
        return 1.0 + 0.02 * jax.random.normal(k, shape, f32)

    return {
        "x": jax.random.normal(ks[0], (BATCH, SEQ, D_MODEL), f32),
        "positions": jnp.tile(jnp.arange(SEQ, dtype=jnp.int32)[None, :], (BATCH, 1)),
        "norm_w": gain(ks[1], (DEPTH, D_MODEL)),
        "rel_bias": 0.5 * jax.random.normal(ks[2], (NUM_BUCKETS, A_HEADS + B_HEADS), f32),
        "ab_w_in": dense(ks[3], (N_AB, D_MODEL, AB_IN)),
        "ab_sinks": jax.random.normal(ks[4], (N_AB, A_HEADS), f32),
        "ab_w_out": dense(ks[5], (N_AB, AB_WIDTH, D_MODEL)),
        "c_w_in": dense(ks[6], (N_C, D_MODEL, C_IN)),
        "c_q_norm": gain(ks[7], (N_C, C_Q_RANK)),
        "c_w_qb": dense(ks[8], (N_C, C_Q_RANK, C_HEADS * (C_NOPE + C_ROPE))),
        "c_kv_norm": gain(ks[9], (N_C, C_KV_RANK)),
        "c_w_kvb": dense(ks[10], (N_C, C_KV_RANK, C_HEADS * (C_NOPE + C_V))),
        "c_w_out": dense(ks[11], (N_C, C_WIDTH, D_MODEL)),
        "final_norm": gain(ks[12], (D_MODEL,)),
    }


def reference(x, positions, norm_w, rel_bias, ab_w_in, ab_sinks, ab_w_out,
              c_w_in, c_q_norm, c_w_qb, c_kv_norm, c_w_kvb, c_w_out, final_norm):
    for layer in range(DEPTH):
        h = rmsnorm(x, norm_w[layer])
        i = layer // 2
        if layer % 2 == 0:
            y = swa_dilated_layer(h, ab_w_in[i], ab_sinks[i], ab_w_out[i], rel_bias)
        else:
            y = mla_layer(h, positions, c_w_in[i], c_q_norm[i], c_w_qb[i],
                          c_kv_norm[i], c_w_kvb[i], c_w_out[i])
        x = x + y
    return rmsnorm(x, final_norm)
```

```cpp
#include <hip/hip_runtime.h>
#include <cstdio>
#include <cstdint>

#ifndef FAST_GEMM
#define FAST_GEMM 1
#endif
#ifndef FAST_MLA
#define FAST_MLA 1
#endif
#ifndef MLA_V2
#define MLA_V2 1
#endif
#ifndef FAST_BAND
#define FAST_BAND 1
#endif

#if defined(PROBE_KIND)
#define PROBE_DRY_REPS(K_, CALL) do { if ((K_) == PROBE_KIND) { for (int rep_ = 0; rep_ < PROBE_N; ++rep_) { CALL; __syncthreads(); } } } while (0)
#define PROBE_REPS(K_, COND) (((K_) == PROBE_KIND && (COND)) ? 1 + PROBE_N : 1)
#else
#define PROBE_DRY_REPS(K_, CALL) do { } while (0)
#define PROBE_REPS(K_, COND) 1
#endif

constexpr int NB = 4, S = 4096, T = NB * S, DM = 1024;
constexpr int AB_IN = 3328, QKV_W = 2304;
constexpr int C_IN = 1440, C_INP = 1536;
constexpr float EPS = 1e-6f;
constexpr float LOG2E = 1.4426950408889634f;
constexpr float CQ_AB = 0.125f * LOG2E;
constexpr float CQ_C = 0.10206207261596577f * LOG2E;

constexpr size_t MiB = 1u << 20;
constexpr size_t WS_CTL = 0;
constexpr size_t WS_FCNT = 32768;
constexpr size_t WS_SSQ = 1 * MiB;
constexpr size_t WS_SSQQ = 2 * MiB;
constexpr size_t WS_SSQKV = 2 * MiB + 256 * 1024;
constexpr size_t WS_ROPE = 3 * MiB;
constexpr size_t WS_BT = 5 * MiB;
constexpr size_t WS_W = 6 * MiB;
constexpr size_t W_ABIN = WS_W;
constexpr size_t W_ABOUT = W_ABIN + 2 * (size_t)AB_IN * DM * 2;
constexpr size_t W_CIN = W_ABOUT + 2 * (size_t)DM * DM * 2;
constexpr size_t W_CQB = W_CIN + 2 * (size_t)C_INP * DM * 2;
constexpr size_t W_CKVB = W_CQB + 2 * (size_t)1536 * 256 * 2;
constexpr size_t W_COUT = W_CKVB + 2 * (size_t)2048 * 128 * 2;
constexpr size_t W_END = W_COUT + 2 * (size_t)DM * DM * 2;
static_assert(W_END <= 38 * MiB, "weights");
constexpr size_t WS_XB = 38 * MiB;
constexpr size_t WS_G = 70 * MiB;
constexpr size_t WS_R = 102 * MiB;
constexpr size_t WS_QKV = WS_R;
constexpr size_t WS_OC = WS_R + 72 * MiB;
constexpr size_t WS_LSE = WS_OC + 48 * MiB;
constexpr size_t WS_CQ = WS_R;
constexpr size_t WS_CKV = WS_R + 8 * MiB;
constexpr size_t WS_KPE = WS_R + 12 * MiB;
constexpr size_t WS_Q = WS_R + 13 * MiB;
constexpr size_t WS_K = WS_Q + 48 * MiB;
constexpr size_t WS_V = WS_K + 32 * MiB;
constexpr size_t WS_END = WS_V + 32 * MiB;
static_assert(WS_END <= 256 * MiB, "workspace");

typedef unsigned short bf16_t;
typedef short bf16x8 __attribute__((ext_vector_type(8)));
typedef float f32x4 __attribute__((ext_vector_type(4)));
typedef float f32x2 __attribute__((ext_vector_type(2)));
typedef unsigned u32x4 __attribute__((ext_vector_type(4)));
typedef unsigned u32x2 __attribute__((ext_vector_type(2)));
typedef __bf16 bf16x2_t __attribute__((ext_vector_type(2)));
#define LAS __attribute__((address_space(3)))

__device__ __forceinline__ unsigned pk2(float lo, float hi) { f32x2 v = {lo, hi}; bf16x2_t b = __builtin_convertvector(v, bf16x2_t); return __builtin_bit_cast(unsigned, b); }
__device__ __forceinline__ float bflo(unsigned w) { return __uint_as_float(w << 16); }
__device__ __forceinline__ float bfhi(unsigned w) { return __uint_as_float(w & 0xffff0000u); }
__device__ __forceinline__ float bf2f(bf16_t h) { return __uint_as_float((unsigned)h << 16); }
__device__ __forceinline__ float silu_f(float v) { return v / (1.f + __expf(-v)); }
__device__ __forceinline__ float dot8(bf16x8 a, bf16x8 b, float acc) {
    const u32x4 ua = __builtin_bit_cast(u32x4, a), ub = __builtin_bit_cast(u32x4, b);
#pragma unroll
    for (int i = 0; i < 4; ++i) { acc = fmaf(bflo(ua[i]), bflo(ub[i]), acc); acc = fmaf(bfhi(ua[i]), bfhi(ub[i]), acc); }
    return acc;
}
__device__ __forceinline__ int lane_id() { unsigned z = 0u; asm volatile("" : "+v"(z)); return (int)__builtin_amdgcn_mbcnt_hi(~0u, __builtin_amdgcn_mbcnt_lo(~0u, z)); }
__device__ __forceinline__ float wave_sum(float v) {
#pragma unroll
    for (int o = 1; o < 64; o <<= 1) v += __shfl_xor(v, o);
    return v;
}

constexpr int BM = 256, NXCD = 8, WGM = 8;
struct Unit { int pm, pn; };
struct Gemm { const bf16_t* A; const bf16_t* Bt; int M, N, K, pad; };
struct StaticOrder {
    int nM, nN, nwg, G, c;
    __device__ void init(int M, int N, int G_, int c_) { nM = M / BM; nN = N / BM; nwg = nM * nN; G = G_; c = c_; }
    __device__ bool next(int i, Unit& u) const {
        const long L = (long)i * G + c; if (L >= nwg) return false;
        int wgid = (int)L; { const int q = nwg / NXCD, r = nwg % NXCD, xcd = wgid % NXCD, off = wgid / NXCD; wgid = (xcd < r ? xcd * (q + 1) : r * (q + 1) + (xcd - r) * q) + off; }
        const int nig = WGM * nN, gid = wgid / nig, fm = gid * WGM, gsz = (nM - fm) < WGM ? (nM - fm) : WGM;
        u.pm = fm + ((wgid % nig) % gsz); u.pn = (wgid % nig) / gsz; return true;
    }
    __device__ __forceinline__ void a_ready(const Unit&) const {}
    __device__ __forceinline__ void done(const Unit&) const {}
};

struct ListOrder {
    int first, cnt, nN;
    __device__ bool next(int i, Unit& u) const { if (i >= cnt) return false; const int L = first + i; u.pm = L / nN; u.pn = L - u.pm * nN; return true; }
    __device__ __forceinline__ void a_ready(const Unit&) const {}
    __device__ __forceinline__ void done(const Unit&) const {}
};

__device__ __forceinline__ float rowscale16(const float* ssq, int row) {
    const f32x4* p = (const f32x4*)(ssq + (size_t)row * 16);
    const f32x4 a = p[0], b = p[1], c = p[2], d = p[3];
    const float s = ((a.x + a.y) + (a.z + a.w)) + ((b.x + b.y) + (b.z + b.w)) + ((c.x + c.y) + (c.z + c.w)) + ((d.x + d.y) + (d.z + d.w));
    return rsqrtf(s * (1.f / 1024.f) + EPS);
}
__device__ __forceinline__ float rowscale4(const float* ssq, int row, float inv_n) {
    const f32x4 a = *(const f32x4*)(ssq + (size_t)row * 4);
    return rsqrtf(((a.x + a.y) + (a.z + a.w)) * inv_n + EPS);
}

__device__ __forceinline__ void load_rowscales16(const float* ssq, int row0  , int fq, float mul, float (&rs)[2][4]) {
    f32x4 v[2][4];
#pragma unroll
    for (int ai = 0; ai < 2; ++ai)
#pragma unroll
        for (int m = 0; m < 4; ++m) v[ai][m] = *(const f32x4*)(ssq + (size_t)(row0 + ai * 128 + m * 16) * 16 + 4 * fq);
#pragma unroll
    for (int ai = 0; ai < 2; ++ai)
#pragma unroll
        for (int m = 0; m < 4; ++m) {
            float t = (v[ai][m][0] + v[ai][m][1]) + (v[ai][m][2] + v[ai][m][3]);
            t += __shfl_xor(t, 16); t += __shfl_xor(t, 32);
            rs[ai][m] = rsqrtf(t * (1.f / 1024.f) + EPS) * mul;
        }
}
__device__ __forceinline__ void load_rowscales4(const float* ssq, int row0, float inv_n, float mul, float (&rs)[2][4]) {
    f32x4 v[2][4];
#pragma unroll
    for (int ai = 0; ai < 2; ++ai)
#pragma unroll
        for (int m = 0; m < 4; ++m) v[ai][m] = *(const f32x4*)(ssq + (size_t)(row0 + ai * 128 + m * 16) * 4);
#pragma unroll
    for (int ai = 0; ai < 2; ++ai)
#pragma unroll
        for (int m = 0; m < 4; ++m) rs[ai][m] = rsqrtf(((v[ai][m][0] + v[ai][m][1]) + (v[ai][m][2] + v[ai][m][3])) * inv_n + EPS) * mul;
}

__device__ __forceinline__ void lds_rowscales(const LAS float* rst, int wr, int fr, float mul, float (&rs)[2][4]) {
#pragma unroll
    for (int ai = 0; ai < 2; ++ai)
#pragma unroll
        for (int m = 0; m < 4; ++m) rs[ai][m] = rst[wr * 64 + fr + ai * 128 + m * 16] * mul;
}
struct EpiABin {
    static constexpr bool PERM = true, AFTER_DRAIN = false;
    bf16_t* QKV; bf16_t* G; const float* ssq;
    static constexpr int RS_KIND = 16; __device__ __forceinline__ const float* rs_ptr() const { return ssq; } __device__ __forceinline__ float rs_inv() const { return 1.f / 1024.f; }
    template <bool LRS = false>
    __device__ __forceinline__ void operator()(const f32x4 (&acc)[2][2][4][2], const Unit& u, int wr, int wc, int fr, int fq, const LAS float* rst = nullptr) const {
        const int pn = u.pn;
        const int mode = (pn >= 9) ? 2 : ((pn < 2 || pn == 3 || pn == 4) ? 1 : 0);
        const int row0 = u.pm * BM + wr * 64 + fr;
        float rs[2][4]; if (LRS) lds_rowscales(rst, wr, fr, mode == 1 ? CQ_AB : 1.f, rs); else load_rowscales16(ssq, row0, fq, mode == 1 ? CQ_AB : 1.f, rs);
#pragma unroll
        for (int ai = 0; ai < 2; ++ai)
#pragma unroll
            for (int m = 0; m < 4; ++m) {
                const int row = row0 + ai * 128 + m * 16;
#pragma unroll
                for (int bj = 0; bj < 2; ++bj) {
                    f32x4 v0 = acc[ai][bj][m][0] * rs[ai][m], v1 = acc[ai][bj][m][1] * rs[ai][m];
                    if (mode == 2) {
#pragma unroll
                        for (int e = 0; e < 4; ++e) { v0[e] = silu_f(v0[e]); v1[e] = silu_f(v1[e]); }
                    }
                    const int col = pn * BM + bj * 128 + wc * 32 + 8 * fq;
                    u32x4 w; w.x = pk2(v0[0], v0[1]); w.y = pk2(v0[2], v0[3]); w.z = pk2(v1[0], v1[1]); w.w = pk2(v1[2], v1[3]);
                    if (mode == 2) *(u32x4*)(G + (size_t)row * DM + (col - QKV_W)) = w;
                    else *(u32x4*)(QKV + (size_t)row * QKV_W + col) = w;
                }
            }
    }
};
struct EpiABinHalf {
    static constexpr bool PERM = true, AFTER_DRAIN = false;
    bf16_t* G; const float* ssq; int colofs, pad;
    static constexpr int RS_KIND = 16; __device__ __forceinline__ const float* rs_ptr() const { return ssq; } __device__ __forceinline__ float rs_inv() const { return 1.f / 1024.f; }
    template <bool LRS = false>
    __device__ __forceinline__ void operator()(const f32x4 (&acc)[2][2][4][2], const Unit& u, int wr, int wc, int fr, int fq, const LAS float* rst = nullptr) const {
        const int row0 = u.pm * BM + wr * 64 + fr;
        float rs[2][4]; if (LRS) lds_rowscales(rst, wr, fr, 1.f, rs); else load_rowscales16(ssq, row0, fq, 1.f, rs);
#pragma unroll
        for (int ai = 0; ai < 2; ++ai)
#pragma unroll
            for (int m = 0; m < 4; ++m) {
                const int row = row0 + ai * 128 + m * 16;
                f32x4 v0 = acc[ai][0][m][0] * rs[ai][m], v1 = acc[ai][0][m][1] * rs[ai][m];
#pragma unroll
                for (int e = 0; e < 4; ++e) { v0[e] = silu_f(v0[e]); v1[e] = silu_f(v1[e]); }
                u32x4 w; w.x = pk2(v0[0], v0[1]); w.y = pk2(v0[2], v0[3]); w.z = pk2(v1[0], v1[1]); w.w = pk2(v1[2], v1[3]);
                *(u32x4*)(G + (size_t)row * DM + (12 * BM - QKV_W) + colofs + wc * 32 + 8 * fq) = w;
            }
    }
};
constexpr int XLP = 4096;
typedef float f32x2v __attribute__((ext_vector_type(2)));
__device__ __forceinline__ unsigned pk4_bf8(float a0, float a1, float a2, float a3) {
    int w = __builtin_amdgcn_cvt_pk_bf8_f32(a0, a1, 0, false); w = __builtin_amdgcn_cvt_pk_bf8_f32(a2, a3, w, true); return (unsigned)w;
}
__device__ __forceinline__ void split_hilo(const f32x4& x0, const f32x4& x1, u32x4& hi, u32x2& lo) {
    hi.x = pk2(x0[0], x0[1]); hi.y = pk2(x0[2], x0[3]); hi.z = pk2(x1[0], x1[1]); hi.w = pk2(x1[2], x1[3]);
    lo.x = pk4_bf8(x0[0] - bflo(hi.x), x0[1] - bfhi(hi.x), x0[2] - bflo(hi.y), x0[3] - bfhi(hi.y));
    lo.y = pk4_bf8(x1[0] - bflo(hi.z), x1[1] - bfhi(hi.z), x1[2] - bflo(hi.w), x1[3] - bfhi(hi.w));
}
__device__ __forceinline__ void join_hilo(const u32x4& hi, const u32x2& lo, f32x4& x0, f32x4& x1) {
    const f32x2v a = __builtin_amdgcn_cvt_pk_f32_bf8((int)lo.x, false), b = __builtin_amdgcn_cvt_pk_f32_bf8((int)lo.x, true);
    const f32x2v c = __builtin_amdgcn_cvt_pk_f32_bf8((int)lo.y, false), d = __builtin_amdgcn_cvt_pk_f32_bf8((int)lo.y, true);
    x0[0] = bflo(hi.x) + a.x; x0[1] = bfhi(hi.x) + a.y; x0[2] = bflo(hi.y) + b.x; x0[3] = bfhi(hi.y) + b.y;
    x1[0] = bflo(hi.z) + c.x; x1[1] = bfhi(hi.z) + c.y; x1[2] = bflo(hi.w) + d.x; x1[3] = bfhi(hi.w) + d.y;
}
struct EpiOut {
    static constexpr bool PERM = true, AFTER_DRAIN = false;
    bf16_t* XB; unsigned char* XL; float* ssq;
    static constexpr int RS_KIND = 0; __device__ __forceinline__ const float* rs_ptr() const { return nullptr; } __device__ __forceinline__ float rs_inv() const { return 0.f; }
    template <bool LRS = false>
    __device__ __forceinline__ void operator()(const f32x4 (&acc)[2][2][4][2], const Unit& u, int wr, int wc, int fr, int fq, const LAS float* rst = nullptr) const {
        const int row0 = u.pm * BM + wr * 64 + fr, col0 = u.pn * BM + wc * 32 + 8 * fq;
#pragma unroll
        for (int ai = 0; ai < 2; ++ai) {
            u32x4 bh[4][2]; u32x2 bl[4][2];
#pragma unroll
            for (int m = 0; m < 4; ++m)
#pragma unroll
                for (int bj = 0; bj < 2; ++bj) {
                    const size_t r = (size_t)(row0 + ai * 128 + m * 16);
                    bh[m][bj] = *(const u32x4*)(XB + r * DM + col0 + bj * 128); bl[m][bj] = *(const u32x2*)(XL + r * XLP + col0 + bj * 128);
                }
            asm volatile("" ::: "memory");
#pragma unroll
            for (int m = 0; m < 4; ++m) {
                const size_t r = (size_t)(row0 + ai * 128 + m * 16);
                float ss = 0.f;
#pragma unroll
                for (int bj = 0; bj < 2; ++bj) {
                    f32x4 x0, x1; join_hilo(bh[m][bj], bl[m][bj], x0, x1);
                    x0 += acc[ai][bj][m][0]; x1 += acc[ai][bj][m][1];
                    u32x4 hi; u32x2 lo; split_hilo(x0, x1, hi, lo);
                    *(u32x4*)(XB + r * DM + col0 + bj * 128) = hi; *(u32x2*)(XL + r * XLP + col0 + bj * 128) = lo;
                    ss += ((x0[0] * x0[0] + x0[1] * x0[1]) + (x0[2] * x0[2] + x0[3] * x0[3])) + ((x1[0] * x1[0] + x1[1] * x1[1]) + (x1[2] * x1[2] + x1[3] * x1[3]));
                }
                ss += __shfl_xor(ss, 16); ss += __shfl_xor(ss, 32);
                if (fq == 0) ssq[r * 16 + u.pn * 4 + wc] = ss;
            }
            asm volatile("" ::: "memory");
        }
    }
};
struct EpiOutFin {
    static constexpr bool PERM = true, AFTER_DRAIN = true;
    const bf16_t* XB; const unsigned char* XL; float* out; float* ssq; unsigned* cnt; const float* fw;
    static constexpr int RS_KIND = 0; __device__ __forceinline__ const float* rs_ptr() const { return nullptr; } __device__ __forceinline__ float rs_inv() const { return 0.f; }
    __device__ __forceinline__ void fused(f32x4 (&acc)[2][2][4][2], const Unit& u, int wr, int wc, int fr, int fq, LAS unsigned char* lds, int wid, int lane) const {
        const int row0 = u.pm * BM + wr * 64 + fr, col0 = u.pn * BM + wc * 32 + 8 * fq;
#pragma unroll
        for (int ai = 0; ai < 2; ++ai) {
            u32x4 bh[4][2]; u32x2 bl[4][2];
#pragma unroll
            for (int m = 0; m < 4; ++m)
#pragma unroll
                for (int bj = 0; bj < 2; ++bj) {
                    const size_t r = (size_t)(row0 + ai * 128 + m * 16);
                    bh[m][bj] = *(const u32x4*)(XB + r * DM + col0 + bj * 128); bl[m][bj] = *(const u32x2*)(XL + r * XLP + col0 + bj * 128);
                }
            asm volatile("" ::: "memory");
#pragma unroll
            for (int m = 0; m < 4; ++m) {
                float ss = 0.f;
#pragma unroll
                for (int bj = 0; bj < 2; ++bj) {
                    f32x4 x0, x1; join_hilo(bh[m][bj], bl[m][bj], x0, x1);
                    x0 += acc[ai][bj][m][0]; x1 += acc[ai][bj][m][1];
                    acc[ai][bj][m][0] = x0; acc[ai][bj][m][1] = x1;
                    ss += ((x0[0] * x0[0] + x0[1] * x0[1]) + (x0[2] * x0[2] + x0[3] * x0[3])) + ((x1[0] * x1[0] + x1[1] * x1[1]) + (x1[2] * x1[2] + x1[3] * x1[3]));
                }
                ss += __shfl_xor(ss, 16); ss += __shfl_xor(ss, 32);
                if (fq == 0) __hip_atomic_store(ssq + (size_t)(row0 + ai * 128 + m * 16) * 16 + u.pn * 4 + wc, ss, __ATOMIC_RELAXED, __HIP_MEMORY_SCOPE_AGENT);
            }
            asm volatile("" ::: "memory");
        }
        f32x4 wv[2][2];
#pragma unroll
        for (int bj = 0; bj < 2; ++bj)
#pragma unroll
            for (int n = 0; n < 2; ++n) wv[bj][n] = *(const f32x4*)(fw + col0 + bj * 128 + n * 4);
        asm volatile("s_waitcnt vmcnt(0)" ::: "memory");
        __builtin_amdgcn_s_barrier(); asm volatile("" ::: "memory");
        if (wid == 0) {
            if (lane == 0) {
                __hip_atomic_fetch_add(cnt + 64 * u.pm, 1u, __ATOMIC_RELAXED, __HIP_MEMORY_SCOPE_AGENT);
                unsigned sp = 0;
                while (__hip_atomic_load(cnt + 64 * u.pm, __ATOMIC_RELAXED, __HIP_MEMORY_SCOPE_AGENT) < 4u) { __builtin_amdgcn_s_sleep(2); if (++sp > (1u << 22)) break; }
                __builtin_amdgcn_fence(__ATOMIC_ACQUIRE, "agent");
            }
        }
        asm volatile("s_waitcnt vmcnt(0) lgkmcnt(0)" ::: "memory");
        __builtin_amdgcn_s_barrier(); asm volatile("" ::: "memory");
        f32x4 pv[2][4];
#pragma unroll
        for (int ai = 0; ai < 2; ++ai)
#pragma unroll
            for (int m = 0; m < 4; ++m) {
                const float* sp_ = ssq + (size_t)(row0 + ai * 128 + m * 16) * 16 + 4 * fq;
#pragma unroll
                for (int e = 0; e < 4; ++e) pv[ai][m][e] = __hip_atomic_load(sp_ + e, __ATOMIC_RELAXED, __HIP_MEMORY_SCOPE_AGENT);
            }
#pragma unroll
        for (int ai = 0; ai < 2; ++ai)
#pragma unroll
            for (int m = 0; m < 4; ++m) {
                float t = (pv[ai][m][0] + pv[ai][m][1]) + (pv[ai][m][2] + pv[ai][m][3]);
                t += __shfl_xor(t, 16); t += __shfl_xor(t, 32);
                const float rs = rsqrtf(t * (1.f / 1024.f) + EPS);
#pragma unroll
                for (int bj = 0; bj < 2; ++bj)
#pragma unroll
                    for (int n = 0; n < 2; ++n)
                        *(f32x4*)(out + (size_t)(row0 + ai * 128 + m * 16) * DM + col0 + bj * 128 + n * 4) = acc[ai][bj][m][n] * rs * wv[bj][n];
            }
    }
};
struct EpiCin {
    static constexpr bool PERM = false, AFTER_DRAIN = false;
    bf16_t* CQ; bf16_t* CKV; bf16_t* KPE; bf16_t* G; const float* ssq; float* ssqq; float* ssqkv; const float* rope; int pn_off, pad;
    static constexpr int RS_KIND = 16; __device__ __forceinline__ const float* rs_ptr() const { return ssq; } __device__ __forceinline__ float rs_inv() const { return 1.f / 1024.f; }
    template <bool LRS = false>
    __device__ __forceinline__ void operator()(const f32x4 (&acc)[2][2][4][2], const Unit& u, int wr, int wc, int fr, int fq, const LAS float* rst = nullptr) const {
        const int pn = u.pn + pn_off;
        const int row0 = u.pm * BM + wr * 64 + fr;
        float rs[2][4]; if (LRS) lds_rowscales(rst, wr, fr, 1.f, rs); else load_rowscales16(ssq, row0, fq, 1.f, rs);
        if (pn == 0) {
#pragma unroll
            for (int ai = 0; ai < 2; ++ai)
#pragma unroll
                for (int m = 0; m < 4; ++m) {
                    const int row = row0 + ai * 128 + m * 16;
                    float ss = 0.f;
#pragma unroll
                    for (int bj = 0; bj < 2; ++bj)
#pragma unroll
                        for (int n = 0; n < 2; ++n) {
                            const f32x4 v = acc[ai][bj][m][n] * rs[ai][m];
                            u32x2 w; w.x = pk2(v[0], v[1]); w.y = pk2(v[2], v[3]);
                            *(u32x2*)(CQ + (size_t)row * 256 + bj * 128 + wc * 32 + n * 16 + 4 * fq) = w;
                            ss += (v[0] * v[0] + v[1] * v[1]) + (v[2] * v[2] + v[3] * v[3]);
                        }
                    ss += __shfl_xor(ss, 16); ss += __shfl_xor(ss, 32);
                    if (fq == 0) ssqq[(size_t)row * 4 + wc] = ss;
                }
        } else if (pn == 1) {
#pragma unroll
            for (int ai = 0; ai < 2; ++ai) {
                f32x4 cs[4], sn[4];
                if (wc == 0) {
#pragma unroll
                    for (int m = 0; m < 4; ++m) { const float* rp = rope + (size_t)(row0 + ai * 128 + m * 16) * 32 + 4 * fq; cs[m] = *(const f32x4*)rp; sn[m] = *(const f32x4*)(rp + 16); }
                }
                asm volatile("" ::: "memory");
#pragma unroll
                for (int m = 0; m < 4; ++m) {
                    const int row = row0 + ai * 128 + m * 16;
                    float ss = 0.f;
#pragma unroll
                    for (int n = 0; n < 2; ++n) {
                        const f32x4 v = acc[ai][0][m][n] * rs[ai][m];
                        u32x2 w; w.x = pk2(v[0], v[1]); w.y = pk2(v[2], v[3]);
                        *(u32x2*)(CKV + (size_t)row * 128 + wc * 32 + n * 16 + 4 * fq) = w;
                        ss += (v[0] * v[0] + v[1] * v[1]) + (v[2] * v[2] + v[3] * v[3]);
                    }
                    ss += __shfl_xor(ss, 16); ss += __shfl_xor(ss, 32);
                    if (fq == 0) ssqkv[(size_t)row * 4 + wc] = ss;
                    if (wc == 0) {
                        const f32x4 t1 = acc[ai][1][m][0] * rs[ai][m], t2 = acc[ai][1][m][1] * rs[ai][m];
                        const f32x4 o1 = t1 * cs[m] - t2 * sn[m], o2 = t1 * sn[m] + t2 * cs[m];
                        u32x2 w1, w2; w1.x = pk2(o1[0], o1[1]); w1.y = pk2(o1[2], o1[3]); w2.x = pk2(o2[0], o2[1]); w2.y = pk2(o2[2], o2[3]);
                        *(u32x2*)(KPE + (size_t)row * 32 + 4 * fq) = w1;
                        *(u32x2*)(KPE + (size_t)row * 32 + 16 + 4 * fq) = w2;
                    }
                }
                asm volatile("" ::: "memory");
            }
        } else {
#pragma unroll
            for (int ai = 0; ai < 2; ++ai)
#pragma unroll
                for (int m = 0; m < 4; ++m) {
                    const int row = row0 + ai * 128 + m * 16;
#pragma unroll
                    for (int bj = 0; bj < 2; ++bj)
#pragma unroll
                        for (int n = 0; n < 2; ++n) {
                            const f32x4 v = acc[ai][bj][m][n] * rs[ai][m];
                            u32x2 w; w.x = pk2(silu_f(v[0]), silu_f(v[1])); w.y = pk2(silu_f(v[2]), silu_f(v[3]));
                            *(u32x2*)(G + (size_t)row * DM + (pn - 2) * BM + bj * 128 + wc * 32 + n * 16 + 4 * fq) = w;
                        }
                }
        }
    }
};
struct EpiQ {
    static constexpr bool PERM = false, AFTER_DRAIN = false;
    bf16_t* Q; const float* ssqq; const float* rope;
    static constexpr int RS_KIND = 4; __device__ __forceinline__ const float* rs_ptr() const { return ssqq; } __device__ __forceinline__ float rs_inv() const { return 1.f / 256.f; }
    template <bool LRS = false>
    __device__ __forceinline__ void operator()(const f32x4 (&acc)[2][2][4][2], const Unit& u, int wr, int wc, int fr, int fq, const LAS float* rst = nullptr) const {
        const int pn = u.pn;
        const int row0 = u.pm * BM + wr * 64 + fr;
        float rq[2][4]; if (LRS) lds_rowscales(rst, wr, fr, CQ_C, rq); else load_rowscales4(ssqq, row0, 1.f / 256.f, CQ_C, rq);
        if (pn < 4) {
#pragma unroll
            for (int ai = 0; ai < 2; ++ai)
#pragma unroll
                for (int m = 0; m < 4; ++m) {
                    const int row = row0 + ai * 128 + m * 16;
#pragma unroll
                    for (int bj = 0; bj < 2; ++bj)
#pragma unroll
                        for (int n = 0; n < 2; ++n) {
                            const f32x4 v = acc[ai][bj][m][n] * rq[ai][m];
                            const int col = pn * BM + bj * 128 + wc * 32 + n * 16 + 4 * fq, h = col >> 6, d = col & 63;
                            u32x2 w; w.x = pk2(v[0], v[1]); w.y = pk2(v[2], v[3]);
                            *(u32x2*)(Q + (size_t)row * 1536 + h * 96 + d) = w;
                        }
                }
        } else {
#pragma unroll
            for (int ai = 0; ai < 2; ++ai) {
                f32x4 cs[4], sn[4];
#pragma unroll
                for (int m = 0; m < 4; ++m) { const float* rp = rope + (size_t)(row0 + ai * 128 + m * 16) * 32 + 4 * fq; cs[m] = *(const f32x4*)rp; sn[m] = *(const f32x4*)(rp + 16); }
                asm volatile("" ::: "memory");
#pragma unroll
                for (int m = 0; m < 4; ++m) {
                    const int row = row0 + ai * 128 + m * 16;
#pragma unroll
                    for (int bj = 0; bj < 2; ++bj) {
                        const int h = 8 * (pn - 4) + 4 * bj + wc;
                        const f32x4 t1 = acc[ai][bj][m][0] * rq[ai][m], t2 = acc[ai][bj][m][1] * rq[ai][m];
                        const f32x4 o1 = t1 * cs[m] - t2 * sn[m], o2 = t1 * sn[m] + t2 * cs[m];
                        u32x2 w1, w2; w1.x = pk2(o1[0], o1[1]); w1.y = pk2(o1[2], o1[3]); w2.x = pk2(o2[0], o2[1]); w2.y = pk2(o2[2], o2[3]);
                        *(u32x2*)(Q + (size_t)row * 1536 + h * 96 + 64 + 4 * fq) = w1;
                        *(u32x2*)(Q + (size_t)row * 1536 + h * 96 + 80 + 4 * fq) = w2;
                    }
                }
                asm volatile("" ::: "memory");
            }
        }
    }
};
struct EpiKV {
    static constexpr bool PERM = true, AFTER_DRAIN = false;
    bf16_t* K; bf16_t* V; const float* ssqkv;
    static constexpr int RS_KIND = 4; __device__ __forceinline__ const float* rs_ptr() const { return ssqkv; } __device__ __forceinline__ float rs_inv() const { return 1.f / 128.f; }
    template <bool LRS = false>
    __device__ __forceinline__ void operator()(const f32x4 (&acc)[2][2][4][2], const Unit& u, int wr, int wc, int fr, int fq, const LAS float* rst = nullptr) const {
        const int row0 = u.pm * BM + wr * 64 + fr;
        float rk[2][4]; if (LRS) lds_rowscales(rst, wr, fr, 1.f, rk); else load_rowscales4(ssqkv, row0, 1.f / 128.f, 1.f, rk);
#pragma unroll
        for (int ai = 0; ai < 2; ++ai)
#pragma unroll
            for (int m = 0; m < 4; ++m) {
                const int row = row0 + ai * 128 + m * 16;
#pragma unroll
                for (int bj = 0; bj < 2; ++bj) {
                    const int h = 2 * u.pn + bj, cc = wc * 32 + 8 * fq;
                    const f32x4 v0 = acc[ai][bj][m][0] * rk[ai][m], v1 = acc[ai][bj][m][1] * rk[ai][m];
                    u32x4 w; w.x = pk2(v0[0], v0[1]); w.y = pk2(v0[2], v0[3]); w.z = pk2(v1[0], v1[1]); w.w = pk2(v1[2], v1[3]);
                    if (wc < 2) *(u32x4*)(K + (size_t)row * 1024 + h * 64 + cc) = w;
                    else *(u32x4*)(V + (size_t)row * 1024 + h * 64 + (cc - 64)) = w;
                }
            }
    }
};

template <class Epi>
__global__ __launch_bounds__(256) void naive_gemm_k(Gemm g, Epi E) {
    const int tid = threadIdx.x, wc = tid >> 6, lane = tid & 63, fr = lane & 15, fq = lane >> 4;
    const int K = g.K, nN = g.N / BM, nhu = 2 * (g.M / BM) * nN;
    for (int hu = blockIdx.x; hu < nhu; hu += gridDim.x) {
        const int wr = hu & 1; Unit u; u.pm = (hu >> 1) / nN; u.pn = (hu >> 1) % nN;
        f32x4 acc[2][2][4][2];
#pragma unroll
        for (int a = 0; a < 2; ++a)
#pragma unroll
            for (int b = 0; b < 2; ++b)
#pragma unroll
                for (int m = 0; m < 4; ++m)
#pragma unroll
                    for (int n = 0; n < 2; ++n) acc[a][b][m][n] = (f32x4){0.f, 0.f, 0.f, 0.f};
        const bf16_t* Ab = g.A + (size_t)(u.pm * BM + wr * 64 + fr) * K;
        const bf16_t* Bb = g.Bt + (size_t)(u.pn * BM + wc * 32) * K;
#pragma unroll 1
        for (int k0 = 0; k0 < K; k0 += 8) {
#pragma unroll
            for (int ai = 0; ai < 2; ++ai) {
                bf16x8 a[4];
#pragma unroll
                for (int m = 0; m < 4; ++m) a[m] = *(const bf16x8*)(Ab + (size_t)(ai * 128 + m * 16) * K + k0);
#pragma unroll
                for (int bj = 0; bj < 2; ++bj)
#pragma unroll
                    for (int n = 0; n < 2; ++n)
#pragma unroll
                        for (int e = 0; e < 4; ++e) {
                            const int cw = Epi::PERM ? (8 * fq + 4 * n + e) : (16 * n + 4 * fq + e);
                            const bf16x8 b = *(const bf16x8*)(Bb + (size_t)(bj * 128 + cw) * K + k0);
#pragma unroll
                            for (int m = 0; m < 4; ++m) acc[ai][bj][m][n][e] = dot8(a[m], b, acc[ai][bj][m][n][e]);
                        }
            }
        }
        E(acc, u, wr, wc, fr, fq);
    }
}

#define PG8_LAS __attribute__((address_space(3)))
constexpr int BK = 64, HALF = 128, HTB = HALF * BK * 2, STAGE_BYTES = 8 * HTB;
__host__ __device__ __forceinline__ int lds_byte(int r, int c) { const int st = (r >> 4) * 2 + (c >> 5), rr = r & 15, cc = c & 31, ob = rr * 64 + cc * 2; return st * 1024 + (ob ^ (((ob >> 9) & 1) << 5)); }
__host__ __device__ __forceinline__ void stage_rc(int b, int& R, int& C) { const int st = b / 1024, sb = b % 1024, swz = sb ^ (((sb >> 9) & 1) << 5); R = (st >> 1) * 16 + swz / 64; C = (st & 1) * 32 + (swz % 64) / 2; }
__host__ __device__ __forceinline__ int perm32(int rho) { const int n = rho >> 4, i = rho & 15; return 8 * (i >> 2) + 4 * n + (i & 3); }
template <class Epi, class Sched, bool ALIGN_EPI = false, bool SP2 = false, bool HALFN = false>
__device__ __forceinline__ void gemm_phase(PG8_LAS unsigned char* lds, const Gemm g, const Sched& S, const Epi& E, int wave_s) {
    int tid_ = wave_s * 64 + lane_id(); asm volatile("" : "+v"(tid_));
    const int tid = tid_, wid = __builtin_amdgcn_readfirstlane(tid >> 6), lane = tid & 63, wr = wid >> 2, wc = wid & 3, fr = lane & 15, fq = lane >> 4;
    const int K = g.K, nt = K / BK;
    unsigned voffA[2], voffB[2];
#pragma unroll
    for (int i = 0; i < 2; ++i) { int R, C; stage_rc(tid * 16 + i * 8192, R, C); const int Rb = Epi::PERM ? ((R & ~31) + perm32(R & 31)) : R;
        voffA[i] = (unsigned)(R * K + C) * 2u; voffB[i] = (unsigned)(Rb * K + C) * 2u; }
    const size_t kstep = (size_t)(BK * 2);
    const size_t hstep = (size_t)HALF * K * 2;
    const size_t tstep = 2 * hstep;
    const unsigned ldsw = (unsigned)wid * 1024u;
    const int aoff = lds_byte(wr * 64 + fr, fq * 8), boff = lds_byte(wc * 32 + fr, fq * 8);
#define PG8_SA(b, h) (((b) * 2 + (h)) * HTB)
#define PG8_SB(b, h) ((4 + (b) * 2 + (h)) * HTB)
#define PG8_STAGE(bufoff, gbase, voff) do { _Pragma("unroll") for (int _i = 0; _i < 2; ++_i) \
        __builtin_amdgcn_global_load_lds((const unsigned*)((const char*)(gbase) + (voff)[_i]), (PG8_LAS unsigned*)(lds + (bufoff) + ldsw + _i * 8192), 16, 0, 0); } while (0)
#define PG8_LDA(dst, b, h) do { _Pragma("unroll") for (int m = 0; m < 4; ++m) _Pragma("unroll") for (int k = 0; k < 2; ++k) dst[m][k] = *(const PG8_LAS bf16x8*)(lds + PG8_SA(b, h) + aoff + m * 2048 + k * 1024); } while (0)
#define PG8_LDB(dst, b, h) do { _Pragma("unroll") for (int n = 0; n < 2; ++n) _Pragma("unroll") for (int k = 0; k < 2; ++k) dst[n][k] = *(const PG8_LAS bf16x8*)(lds + PG8_SB(b, h) + boff + n * 2048 + k * 1024); } while (0)
#define PG8_MMA(ai, bj, At, Bt) do { __builtin_amdgcn_s_setprio(1); _Pragma("unroll") for (int m = 0; m < 4; ++m) _Pragma("unroll") for (int n = 0; n < 2; ++n) _Pragma("unroll") for (int k = 0; k < 2; ++k) \
        acc[ai][bj][m][n] = __builtin_amdgcn_mfma_f32_16x16x32_bf16(Bt[n][k], At[m][k], acc[ai][bj][m][n], 0, 0, 0); __builtin_amdgcn_s_setprio(0); } while (0)
#define PG8_WAIT_V(n) asm volatile("s_waitcnt vmcnt(" #n ")" ::: "memory")
#define PG8_WAIT_L(n) asm volatile("s_waitcnt lgkmcnt(" #n ")" ::: "memory")
#define PG8_BAR __builtin_amdgcn_s_barrier()
#define PG8_SCHED __builtin_amdgcn_sched_barrier(0)
    Unit cur, nxt; int ui = 0;
    if (!S.next(0, cur)) return;
    f32x4 acc[2][2][4][2];
#pragma unroll
    for (int a = 0; a < 2; ++a)
#pragma unroll
        for (int b = 0; b < 2; ++b)
#pragma unroll
            for (int m = 0; m < 4; ++m)
#pragma unroll
                for (int n = 0; n < 2; ++n) acc[a][b][m][n] = (f32x4){0.f, 0.f, 0.f, 0.f};
    bf16x8 At[4][2], B0[2][2], B1[2][2];
    const char* cA = (const char*)g.A + (size_t)cur.pm * tstep; const char* cB = (const char*)g.Bt + (size_t)cur.pn * tstep;
    S.a_ready(cur);
    constexpr int RS_MAXU = 8, RS_Q = (Epi::RS_KIND == 16) ? 4 : 1;
    unsigned rs_off_ = 8 * HTB; asm volatile("" : "+s"(rs_off_));
    PG8_LAS float* rst = (PG8_LAS float*)(lds + rs_off_);
    f32x4 rsv[RS_MAXU / 2][RS_Q]; bool rsok[RS_MAXU / 2];
    if constexpr (Epi::RS_KIND != 0) {
        const float* rsrc = E.rs_ptr(); const int r_ = tid & 255, jp_ = tid >> 8;
#pragma unroll
        for (int jj = 0; jj < RS_MAXU / 2; ++jj) { Unit uu; rsok[jj] = S.next(jp_ + 2 * jj, uu);
            if (rsok[jj]) { const float* pr = rsrc + (size_t)(uu.pm * BM + r_) * Epi::RS_KIND;
#pragma unroll
                for (int q = 0; q < RS_Q; ++q) rsv[jj][q] = *(const f32x4*)(pr + 4 * q); } }
        asm volatile("" ::: "memory");
    }
#define RS_COMBINE() do { if constexpr (Epi::RS_KIND != 0) { PG8_WAIT_V(8); const float inv_ = E.rs_inv(); const int r_ = tid & 255, jp_ = tid >> 8; \
        _Pragma("unroll") for (int jj = 0; jj < RS_MAXU / 2; ++jj) if (rsok[jj]) { f32x4 t_ = rsv[jj][0]; _Pragma("unroll") for (int q = 1; q < RS_Q; ++q) t_ += rsv[jj][q]; \
            rst[(jp_ + 2 * jj) * 256 + r_] = rsqrtf(((t_[0] + t_[1]) + (t_[2] + t_[3])) * inv_ + EPS); } } } while (0)
    if constexpr (SP2) {
        PG8_STAGE(PG8_SB(0, 0), cB, voffB); PG8_STAGE(PG8_SB(0, 1), cB + hstep, voffB); PG8_STAGE(PG8_SA(0, 0), cA, voffA); PG8_STAGE(PG8_SA(0, 1), cA + hstep, voffA);
        RS_COMBINE();
        if (wr == 1) PG8_BAR;
        PG8_WAIT_V(2); PG8_BAR;
        PG8_STAGE(PG8_SB(1, 0), cB + kstep, voffB); PG8_STAGE(PG8_SA(1, 0), cA + kstep, voffA); PG8_STAGE(PG8_SB(1, 1), cB + hstep + kstep, voffB);
        PG8_WAIT_V(6); PG8_BAR;
    } else {
        PG8_STAGE(PG8_SB(0, 0), cB, voffB); PG8_STAGE(PG8_SA(0, 0), cA, voffA); PG8_STAGE(PG8_SB(0, 1), cB + hstep, voffB); PG8_STAGE(PG8_SA(0, 1), cA + hstep, voffA);
        RS_COMBINE();
        if (wr == 1) PG8_BAR;
        PG8_WAIT_V(4); PG8_BAR;
        PG8_STAGE(PG8_SB(1, 0), cB + kstep, voffB); PG8_STAGE(PG8_SA(1, 0), cA + kstep, voffA); PG8_STAGE(PG8_SB(1, 1), cB + hstep + kstep, voffB);
        PG8_WAIT_V(6); PG8_BAR;
    }
    for (;;) {
        const bool has_next = S.next(ui + 1, nxt);
        const char* nA = has_next ? (const char*)g.A + (size_t)nxt.pm * tstep : cA; const char* nB = has_next ? (const char*)g.Bt + (size_t)nxt.pn * tstep : cB;
        for (int t = 0; t < nt; t += 2) {
            const bool last = (t == nt - 2);
            const char* a1 = cA + (size_t)(t + 1) * kstep;
            const char* a2 = last ? nA : cA + (size_t)(t + 2) * kstep; const char* b2 = last ? nB : cB + (size_t)(t + 2) * kstep;
            const char* a3 = a2 + kstep; const char* b3 = b2 + kstep;
            if (last && has_next) S.a_ready(nxt);
            if constexpr (SP2) {
            PG8_LDB(B0, 0, 0); if constexpr (!HALFN) PG8_LDB(B1, 0, 1); PG8_SCHED; PG8_LDA(At, 0, 0); PG8_STAGE(PG8_SA(1, 1), a1 + hstep, voffA);
            PG8_WAIT_V(8); PG8_WAIT_L(0); PG8_BAR; PG8_MMA(0, 0, At, B0); if constexpr (!HALFN) PG8_MMA(0, 1, At, B1); PG8_BAR; PG8_SCHED;
            PG8_LDA(At, 0, 1); PG8_STAGE(PG8_SB(0, 0), b2, voffB); PG8_STAGE(PG8_SB(0, 1), b2 + hstep, voffB); PG8_STAGE(PG8_SA(0, 0), a2, voffA);
            PG8_WAIT_V(8); PG8_WAIT_L(0); PG8_BAR; PG8_MMA(1, 0, At, B0); if constexpr (!HALFN) PG8_MMA(1, 1, At, B1); PG8_BAR; PG8_SCHED;
            PG8_LDB(B0, 1, 0); if constexpr (!HALFN) PG8_LDB(B1, 1, 1); PG8_SCHED; PG8_LDA(At, 1, 0); PG8_STAGE(PG8_SA(0, 1), a2 + hstep, voffA);
            PG8_WAIT_V(8); PG8_WAIT_L(0); PG8_BAR; PG8_MMA(0, 0, At, B0); if constexpr (!HALFN) PG8_MMA(0, 1, At, B1); PG8_BAR; PG8_SCHED;
            PG8_LDA(At, 1, 1); PG8_STAGE(PG8_SB(1, 0), b3, voffB); PG8_STAGE(PG8_SB(1, 1), b3 + hstep, voffB); PG8_STAGE(PG8_SA(1, 0), a3, voffA);
            PG8_WAIT_V(8); PG8_WAIT_L(0); PG8_BAR; PG8_MMA(1, 0, At, B0); if constexpr (!HALFN) PG8_MMA(1, 1, At, B1); PG8_BAR; PG8_SCHED;
            } else {
            PG8_LDB(B0, 0, 0); PG8_SCHED; PG8_LDA(At, 0, 0); PG8_STAGE(PG8_SA(1, 1), a1 + hstep, voffA);
            PG8_WAIT_L(8); PG8_BAR; PG8_WAIT_L(0); PG8_MMA(0, 0, At, B0); PG8_BAR; PG8_SCHED;
            PG8_LDB(B1, 0, 1); PG8_STAGE(PG8_SB(0, 0), b2, voffB);
            PG8_BAR; PG8_WAIT_L(0); PG8_MMA(0, 1, At, B1); PG8_BAR;
            PG8_LDA(At, 0, 1); PG8_STAGE(PG8_SA(0, 0), a2, voffA);
            PG8_BAR; PG8_WAIT_L(0); PG8_MMA(1, 0, At, B0); PG8_BAR; PG8_SCHED;
            PG8_STAGE(PG8_SB(0, 1), b2 + hstep, voffB);
            PG8_WAIT_V(6); PG8_BAR; PG8_MMA(1, 1, At, B1); PG8_BAR;
            PG8_LDB(B0, 1, 0); PG8_SCHED; PG8_LDA(At, 1, 0); PG8_STAGE(PG8_SA(0, 1), a2 + hstep, voffA);
            PG8_WAIT_L(8); PG8_BAR; PG8_WAIT_L(0); PG8_MMA(0, 0, At, B0); PG8_BAR; PG8_SCHED;
            PG8_LDB(B1, 1, 1); PG8_STAGE(PG8_SB(1, 0), b3, voffB);
            PG8_BAR; PG8_WAIT_L(0); PG8_MMA(0, 1, At, B1); PG8_BAR;
            PG8_LDA(At, 1, 1); PG8_STAGE(PG8_SA(1, 0), a3, voffA);
            PG8_BAR; PG8_WAIT_L(0); PG8_MMA(1, 0, At, B0); PG8_BAR; PG8_SCHED;
            PG8_STAGE(PG8_SB(1, 1), b3 + hstep, voffB);
            PG8_WAIT_V(6); PG8_BAR; PG8_MMA(1, 1, At, B1); PG8_BAR;
            }
        }
        if constexpr (ALIGN_EPI) { if (wr == 0) PG8_BAR; }
        if constexpr (!Epi::AFTER_DRAIN) { const int le_ = lane_id(); E.template operator()<true>(acc, cur, wr, wc, le_ & 15, le_ >> 4, rst + ui * 256); S.done(cur); }
        if (!has_next) break;
#pragma unroll
        for (int a = 0; a < 2; ++a)
#pragma unroll
            for (int b = 0; b < 2; ++b)
#pragma unroll
                for (int m = 0; m < 4; ++m)
#pragma unroll
                    for (int n = 0; n < 2; ++n) acc[a][b][m][n] = (f32x4){0.f, 0.f, 0.f, 0.f};
        cur = nxt; cA = nA; cB = nB; ++ui;
        if constexpr (ALIGN_EPI) { if (wr == 1) PG8_BAR; }
    }
    PG8_WAIT_V(0);
    if constexpr (!ALIGN_EPI) { if (wr == 0) PG8_BAR; }
    PG8_BAR;
    if constexpr (Epi::AFTER_DRAIN) { E.fused(acc, cur, wr, wc, fr, fq, lds, wid, lane); S.done(cur); }
#undef RS_COMBINE
#undef PG8_SA
#undef PG8_SB
#undef PG8_STAGE
#undef PG8_LDA
#undef PG8_LDB
#undef PG8_MMA
#undef PG8_WAIT_V
#undef PG8_WAIT_L
#undef PG8_BAR
#undef PG8_SCHED
}


struct ConvItem { const float* W; const float* kscale; bf16_t* WT; int K, N, srcn0, dstn0, k0; };
__device__ __forceinline__ void conv_load(const ConvItem& c, f32x4 (&v)[8], f32x4& ks0, f32x4& ks1, int lane) {
    const int c8 = lane & 7, r8 = lane >> 3;
    if (c.srcn0 >= 0) {
        const float* p = c.W + (size_t)(c.k0 + r8) * c.N + c.srcn0 + 4 * c8;
#pragma unroll
        for (int r = 0; r < 8; ++r) v[r] = *(const f32x4*)(p + (size_t)(8 * r) * c.N);
    } else {
#pragma unroll
        for (int r = 0; r < 8; ++r) v[r] = (f32x4){0.f, 0.f, 0.f, 0.f};
    }
    ks0 = (f32x4){1.f, 1.f, 1.f, 1.f}; ks1 = ks0;
    if (c.kscale) { ks0 = *(const f32x4*)(c.kscale + c.k0 + 8 * c8); ks1 = *(const f32x4*)(c.kscale + c.k0 + 8 * c8 + 4); }
}
struct ConvOut { bf16_t* p; int K; };
__device__ __forceinline__ void conv_finish(const ConvOut& c, const f32x4 (&v)[8], const f32x4& ks0, const f32x4& ks1, LAS float* scr, int lane) {
    const int c8 = lane & 7, r8 = lane >> 3;
#pragma unroll
    for (int r = 0; r < 8; ++r) {
        LAS float* d = scr + (8 * r + r8) * 33 + 4 * c8;
        d[0] = v[r][0]; d[1] = v[r][1]; d[2] = v[r][2]; d[3] = v[r][3];
    }
    asm volatile("s_waitcnt lgkmcnt(0)" ::: "memory");
#pragma unroll
    for (int j = 0; j < 4; ++j) {
        const int n = r8 + 8 * j; const LAS float* s = scr + (8 * c8) * 33 + n;
        u32x4 o; o.x = pk2(s[0 * 33] * ks0[0], s[1 * 33] * ks0[1]); o.y = pk2(s[2 * 33] * ks0[2], s[3 * 33] * ks0[3]); o.z = pk2(s[4 * 33] * ks1[0], s[5 * 33] * ks1[1]); o.w = pk2(s[6 * 33] * ks1[2], s[7 * 33] * ks1[3]);
        *(u32x4*)(c.p + (size_t)n * c.K + 8 * c8) = o;
    }
    asm volatile("s_waitcnt lgkmcnt(0)" ::: "memory");
}

struct Args {
    const float* x; const int* pos; const float* norm_w; const float* rel_bias; const float* ab_w_in; const float* ab_sinks; const float* ab_w_out;
    const float* c_w_in; const float* c_q_norm; const float* c_w_qb; const float* c_kv_norm; const float* c_w_kvb; const float* c_w_out; const float* final_norm;
    float* out; unsigned char* ws; int ph_lo, ph_hi;
};

__device__ __forceinline__ int t5_bucket(int dist) {
    if (dist < 16) return dist;
    int large = 16 + (int)(logf((float)dist / 16.f) / logf(128.f) * 16.f);
    return large < 31 ? large : 31;
}

template <int PART>
__device__ __forceinline__ void prologue(const Args& a, LAS unsigned char* lds, int gw, int NGW, int lane, int wave) {
    unsigned char* ws = a.ws;
    LAS float* scr = (LAS float*)(lds + wave * 16384);
    constexpr int I_ABIN = 16 * (AB_IN / 32), I_SQ = 16 * 32, I_CIN = 16 * (C_INP / 32), I_CQB = 4 * 48, I_CKVB = 2 * 64;
    constexpr int PER = I_ABIN + I_SQ + I_CIN + I_CQB + I_CKVB + I_SQ;
    constexpr int IT_LO = (PART == 0) ? 0 : (PART == 2) ? PER + I_ABIN : I_ABIN, IT_HI = (PART == 0) ? I_ABIN : (PART == 1) ? PER + I_ABIN : 2 * PER;
    auto item_of = [&](int it) -> ConvItem {
        const int li = it / PER; int r = it % PER;
        if (r < I_ABIN) { const int nb = AB_IN / 32, kb = r / nb, n0 = (r % nb) * 32;
            return ConvItem{a.ab_w_in + (size_t)li * DM * AB_IN, a.norm_w + (2 * li) * DM, (bf16_t*)(ws + W_ABIN) + (size_t)li * AB_IN * DM, DM, AB_IN, n0, n0, kb * 64}; }
        r -= I_ABIN;
        if (r < I_SQ) { const int kb = r / 32, n0 = (r % 32) * 32;
            return ConvItem{a.ab_w_out + (size_t)li * DM * DM, nullptr, (bf16_t*)(ws + W_ABOUT) + (size_t)li * DM * DM, DM, DM, n0, n0, kb * 64}; }
        r -= I_SQ;
        if (r < I_CIN) { const int nb = C_INP / 32, kb = r / nb, n0 = (r % nb) * 32;
            const int src = (n0 < 416) ? n0 : ((n0 < 512) ? -1 : n0 - 96);
            return ConvItem{a.c_w_in + (size_t)li * DM * C_IN, a.norm_w + (2 * li + 1) * DM, (bf16_t*)(ws + W_CIN) + (size_t)li * C_INP * DM, DM, C_IN, src, n0, kb * 64}; }
        r -= I_CIN;
        if (r < I_CQB) { const int kb = r / 48, n0 = (r % 48) * 32;
            const int src = (n0 < 1024) ? ((n0 >> 6) * 96 + (n0 & 63)) : (((n0 - 1024) >> 5) * 96 + 64);
            return ConvItem{a.c_w_qb + (size_t)li * 256 * 1536, a.c_q_norm + li * 256, (bf16_t*)(ws + W_CQB) + (size_t)li * 1536 * 256, 256, 1536, src, n0, kb * 64}; }
        r -= I_CQB;
        if (r < I_CKVB) { const int kb = r / 64, n0 = (r % 64) * 32;
            return ConvItem{a.c_w_kvb + (size_t)li * 128 * 2048, a.c_kv_norm + li * 128, (bf16_t*)(ws + W_CKVB) + (size_t)li * 2048 * 128, 128, 2048, n0, n0, kb * 64}; }
        r -= I_CKVB;
        { const int kb = r / 32, n0 = (r % 32) * 32;
            return ConvItem{a.c_w_out + (size_t)li * DM * DM, nullptr, (bf16_t*)(ws + W_COUT) + (size_t)li * DM * DM, DM, DM, n0, n0, kb * 64}; }
    };
    f32x4 nx[4]; int npos = 0;
    if (PART == 0) { if (gw < T) {
#pragma unroll
        for (int j = 0; j < 4; ++j) nx[j] = ((const f32x4*)(a.x + (size_t)gw * DM) + lane)[64 * j];
        npos = a.pos[gw];
    } }
    {
        ConvOut oa{nullptr, 0}; f32x4 va[8], ka0, ka1; bool have = false;
#pragma unroll 1
        for (int it = IT_LO + gw;; it += NGW) {
            const bool hn = it < IT_HI;
            ConvOut ob{nullptr, 0}; f32x4 vb[8], kb0, kb1;
            if (hn) { const ConvItem c = item_of(it); conv_load(c, vb, kb0, kb1, lane); ob = ConvOut{c.WT + (size_t)c.dstn0 * c.K + c.k0, c.K}; }
            if (have) conv_finish(oa, va, ka0, ka1, scr, lane);
            if (!hn) break;
#pragma unroll
            for (int r = 0; r < 8; ++r) va[r] = vb[r];
            ka0 = kb0; ka1 = kb1; oa = ob; have = true;
        }
    }
    if (PART != 0) return;
    bf16_t* XB = (bf16_t*)(ws + WS_XB); float* ssq = (float*)(ws + WS_SSQ); float* rope = (float*)(ws + WS_ROPE);
    auto do_row = [&](int row, const f32x4 (&v4)[4], int pos) {
        float s = 0.f;
#pragma unroll
        for (int j = 0; j < 4; ++j) {
            const f32x4 v = v4[j];
            s += (v[0] * v[0] + v[1] * v[1]) + (v[2] * v[2] + v[3] * v[3]);
            u32x2 w; w.x = pk2(v[0], v[1]); w.y = pk2(v[2], v[3]);
            const unsigned wl = pk4_bf8(v[0] - bflo(w.x), v[1] - bfhi(w.x), v[2] - bflo(w.y), v[3] - bfhi(w.y));
            *((u32x2*)(XB + (size_t)row * DM) + lane + 64 * j) = w;
            *((unsigned*)((unsigned char*)a.out + (size_t)row * XLP) + lane + 64 * j) = wl;
        }
        s = wave_sum(s);
        if (lane < 16) ssq[(size_t)row * 16 + lane] = (lane == 0) ? s : 0.f;
        if (lane < 32) {
            const int i = lane & 15;
            const float inv_freq = exp2f(-(float)(2 * i) / 32.f * 13.287712379549449f);
            const float ang = (float)pos * inv_freq;
            rope[(size_t)row * 32 + lane] = (lane < 16) ? cosf(ang) : sinf(ang);
        }
    };
    f32x4 nb[4]; int nposb = 0;
    if (gw + NGW < T) {
#pragma unroll
        for (int j = 0; j < 4; ++j) nb[j] = ((const f32x4*)(a.x + (size_t)(gw + NGW) * DM) + lane)[64 * j];
        nposb = a.pos[gw + NGW];
    }
    for (int row = gw; row < T; row += 2 * NGW) {
        f32x4 v4[4]; int pos = npos;
#pragma unroll
        for (int j = 0; j < 4; ++j) v4[j] = nx[j];
        if (row + 2 * NGW < T) {
#pragma unroll
            for (int j = 0; j < 4; ++j) nx[j] = ((const f32x4*)(a.x + (size_t)(row + 2 * NGW) * DM) + lane)[64 * j];
            npos = a.pos[row + 2 * NGW];
        }
        asm volatile("" ::: "memory");
        do_row(row, v4, pos);
        if (row + NGW < T) {
            pos = nposb;
#pragma unroll
            for (int j = 0; j < 4; ++j) v4[j] = nb[j];
            if (row + 3 * NGW < T) {
#pragma unroll
                for (int j = 0; j < 4; ++j) nb[j] = ((const f32x4*)(a.x + (size_t)(row + 3 * NGW) * DM) + lane)[64 * j];
                nposb = a.pos[row + 3 * NGW];
            }
            asm volatile("" ::: "memory");
            do_row(row + NGW, v4, pos);
        }
    }
    float* bt = (float*)(ws + WS_BT);
    for (int i = gw * 64 + lane; i < 4 * 8 * 192; i += NGW * 64) {
        const int cfg = i / (8 * 192), h = (i / 192) % 8, delta = i % 192 - 31;
        const int dil = (cfg <= 1) ? 1 : ((cfg == 2) ? 4 : 16);
        float v = -INFINITY;
        if (delta >= 0 && delta <= 128) v = a.rel_bias[t5_bucket(delta * dil) * 16 + (cfg == 0 ? h : 8 + h)] * LOG2E;
        bt[i] = v;
    }
}

__device__ __forceinline__ void final_norm_phase(const Args& a, int gw, int NGW, int lane) {
    const float* ssq = (const float*)(a.ws + WS_SSQ); const bf16_t* XB = (const bf16_t*)(a.ws + WS_XB); const unsigned char* XL = (const unsigned char*)a.out;
    for (int row = gw; row < T; row += NGW) {
        const float rs = rowscale16(ssq, row);
        u32x2 h[4]; unsigned l[4];
#pragma unroll
        for (int j = 0; j < 4; ++j) { h[j] = *((const u32x2*)(XB + (size_t)row * DM) + lane + 64 * j); l[j] = *((const unsigned*)(XL + (size_t)row * XLP) + lane + 64 * j); }
        asm volatile("" ::: "memory");
        f32x4* xr = (f32x4*)(a.out + (size_t)row * DM) + lane;
        const f32x4* wv = (const f32x4*)a.final_norm + lane;
#pragma unroll
        for (int j = 0; j < 4; ++j) { const f32x2v la = __builtin_amdgcn_cvt_pk_f32_bf8((int)l[j], false), lb = __builtin_amdgcn_cvt_pk_f32_bf8((int)l[j], true);
            f32x4 v; v[0] = bflo(h[j].x) + la.x; v[1] = bfhi(h[j].x) + la.y; v[2] = bflo(h[j].y) + lb.x; v[3] = bfhi(h[j].y) + lb.y;
            xr[64 * j] = v * rs * wv[64 * j]; }
    }
}

typedef float f32x16 __attribute__((ext_vector_type(16)));
typedef short s16x4 __attribute__((ext_vector_type(4)));

namespace mla2 {
constexpr int KSLOT = 12288, VSLOT = 8192;
constexpr int L_K = 0, L_V = 3 * KSLOT, L_WS = L_V + 3 * VSLOT, L_OST = L_WS + 8 * 256, L_QS = L_OST + 8 * 4096, L_END = L_QS + 8 * 6144;
constexpr int THRL = 8;
typedef __attribute__((address_space(3))) const char* lds_cptr;
typedef short v4i16_t __attribute__((ext_vector_type(4)));
#define SBAR() __builtin_amdgcn_sched_barrier(0)
#define WAIT_BAR(N) asm volatile("s_waitcnt vmcnt(" #N ") lgkmcnt(0)\n\ts_barrier" ::: "memory")
__device__ __forceinline__ int crow(int r, int hi) { return (r & 3) + 8 * (r >> 2) + 4 * hi; }
__device__ __forceinline__ void glds16(const void* sbase, unsigned voff, unsigned lds_dst) { unsigned keep;
    asm volatile("s_mov_b32 %0, m0\n\ts_mov_b32 m0, %2\n\ts_nop 0\n\tglobal_load_lds_dwordx4 %1, %3\n\ts_mov_b32 m0, %0" : "=&s"(keep) : "v"(voff), "s"(lds_dst), "s"(sbase) : "memory"); }
__device__ __forceinline__ s16x4 vtr(lds_cptr p) { return __builtin_bit_cast(s16x4, __builtin_amdgcn_ds_read_tr16_b64_v4i16((__attribute__((address_space(3))) v4i16_t*)p)); }
__device__ __forceinline__ void cmask(f32x16& p0, f32x16& p1, int jb, int qrel, int hi) {
    const int kb = 64 * jb + 4 * hi;
#pragma unroll
    for (int r = 0; r < 16; ++r) { const int kv = kb + (r & 3) + 8 * (r >> 2); if (kv > qrel) p0[r] = -INFINITY; if (kv + 32 > qrel) p1[r] = -INFINITY; }
}
#define MX3(a, b, c) __builtin_fmaxf(__builtin_fmaxf((a), (b)), (c))
__device__ __forceinline__ float rowmax(const f32x16& p0, const f32x16& p1) {
    float a = MX3(p0[0], p0[1], p1[0]), b = MX3(p0[2], p0[3], p1[1]); a = MX3(a, p1[2], p1[3]);
#pragma unroll
    for (int r = 4; r < 16; r += 4) { a = MX3(a, p0[r], p0[r + 1]); b = MX3(b, p0[r + 2], p0[r + 3]); a = MX3(a, p1[r], p1[r + 1]); b = MX3(b, p1[r + 2], p1[r + 3]); }
    float m = __builtin_fmaxf(a, b);
    auto rr = __builtin_amdgcn_permlane32_swap(__float_as_uint(m), __float_as_uint(m), false, false);
    return __builtin_fmaxf(__uint_as_float(rr[0]), __uint_as_float(rr[1]));
}

template <bool DRY>
__device__ __forceinline__ void unit(int b, int h, int qb, const bf16_t* __restrict__ Q, const bf16_t* __restrict__ K, const bf16_t* __restrict__ KPE, const bf16_t* __restrict__ V, bf16_t* G, char* shm, int wid, int& s0, bool pre, bool has_next, int nqb) {
    const int lane = lane_id(), r32 = lane & 31, hi = lane >> 5;
    const long rowbase = (long)b * S; const int q0 = qb * 256;
    const bf16_t* Qw = Q + (rowbase + q0 + wid * 32) * 1536 + h * 96;
    const bf16_t* Kh = K + rowbase * 1024 + h * 64; const bf16_t* Ph = KPE + rowbase * 32; const bf16_t* Vh = V + rowbase * 1024 + h * 64;
    const unsigned lds0 = (unsigned)(uintptr_t)shm;
    float* wsf = (float*)(shm + L_WS) + wid * 64;
    const unsigned koffA = (unsigned)((lane * 1024 + wid * 8) * 2), koffB = (unsigned)((lane * 32 + (wid & 3) * 8) * 2);
    const unsigned voffv = (unsigned)(((16 * (wid & 3) + (lane >> 2)) * 1024 + (wid >> 2) * 32 + (lane & 3) * 8) * 2);
    const unsigned kdstA = lds0 + L_K + wid * 1024, kdstB = lds0 + L_K + (8 + (wid & 3)) * 1024, vdst = lds0 + L_V + wid * 1024;
#define DMA_K(t, sl) do { glds16(Kh + (long)(t) * 64 * 1024, koffA, (unsigned)__builtin_amdgcn_readfirstlane(kdstA + (sl) * KSLOT)); \
                          glds16(Ph + (long)(t) * 64 * 32, koffB, (unsigned)__builtin_amdgcn_readfirstlane(kdstB + (sl) * KSLOT)); } while (0)
#define DMA_V(t, sl) glds16(Vh + (long)(t) * 64 * 1024, voffv, (unsigned)__builtin_amdgcn_readfirstlane(vdst + (sl) * VSLOT))
    const lds_cptr shm3 = (lds_cptr)shm;
    const lds_cptr kp0 = shm3 + L_K + hi * 1024 + r32 * 16;
    const lds_cptr vp0 = shm3 + L_V + ((lane >> 4) & 1) * 32 + (lane & 3) * 8 + (4 * hi + ((lane & 15) >> 2)) * 64;
    const int NT = 4 * (qb + 1);
    const int s1 = (s0 == 2) ? 0 : s0 + 1, s2 = (s1 == 2) ? 0 : s1 + 1;
    if (!pre) { DMA_K(0, s0); DMA_V(0, s0); DMA_K(1, s1); DMA_K(2, s2); }
    const lds_cptr qsp = shm3 + L_QS + wid * 6144 + lane * 16;
    if (!pre) {
        bf16x8 qg[6];
#pragma unroll
        for (int s = 0; s < 6; ++s) qg[s] = *(const bf16x8*)(Qw + (long)r32 * 1536 + s * 16 + hi * 8);
#pragma unroll
        for (int s = 0; s < 6; ++s) *(__attribute__((address_space(3))) bf16x8*)(qsp + s * 1024) = qg[s];
    }
    bf16x8 qr[6];
#pragma unroll
    for (int s = 0; s < 6; ++s) qr[s] = *(const __attribute__((address_space(3))) bf16x8*)(qsp + s * 1024);
    float mhat = 0.f, l_reg = 0.f; f32x16 o[2]; o[0] = f32x16{}; o[1] = f32x16{}; const f32x16 zero16 = f32x16{};
    f32x16 negm = f32x16{};
    const int qrel = wid * 32 + r32;
    bool resc = false;
    bf16x8 kf[12];
#define KLOAD2(sl, j) do { kf[2 * (j)] = *(const __attribute__((address_space(3))) bf16x8*)(kp0 + (sl) * KSLOT + (j) * 2048); \
                           kf[2 * (j) + 1] = *(const __attribute__((address_space(3))) bf16x8*)(kp0 + (sl) * KSLOT + (j) * 2048 + 512); } while (0)
#define RESC() do { if (resc) { asm volatile("s_waitcnt lgkmcnt(0)" ::: "memory"); \
        _Pragma("unroll") for (int d_ = 0; d_ < 2; ++d_) _Pragma("unroll") for (int r = 0; r < 16; ++r) o[d_][r] *= wsf[crow(r, hi)]; } } while (0)
    f32x16 pA0, pA1, pB0, pB1;
    int sl_prev = s0, sl_cur = s0, sl_next = s1;
#define ROT() do { sl_prev = sl_cur; sl_cur = sl_next; sl_next = (sl_next == 2) ? 0 : sl_next + 1; } while (0)
    WAIT_BAR(5);
    { KLOAD2(s0, 0); KLOAD2(s0, 1); KLOAD2(s0, 2); KLOAD2(s0, 3); KLOAD2(s0, 4); KLOAD2(s0, 5);
      pA0 = __builtin_amdgcn_mfma_f32_32x32x16_bf16(kf[0], qr[0], zero16, 0, 0, 0); pA1 = __builtin_amdgcn_mfma_f32_32x32x16_bf16(kf[1], qr[0], zero16, 0, 0, 0);
#pragma unroll
      for (int s = 1; s < 6; ++s) { pA0 = __builtin_amdgcn_mfma_f32_32x32x16_bf16(kf[2 * s], qr[s], pA0, 0, 0, 0); pA1 = __builtin_amdgcn_mfma_f32_32x32x16_bf16(kf[2 * s + 1], qr[s], pA1, 0, 0, 0); }
      if (NT == 4) cmask(pA0, pA1, 0, qrel, hi);
      const float rm = rowmax(pA0, pA1); mhat = rm;
#pragma unroll
      for (int r = 0; r < 16; ++r) { pA0[r] -= rm; pA1[r] -= rm; negm[r] = -rm; }
      asm volatile("" : "+v"(negm));
#pragma unroll
      for (int r = 0; r < 16; ++r) { pA0[r] = __builtin_amdgcn_exp2f(pA0[r]); pA1[r] = __builtin_amdgcn_exp2f(pA1[r]); } }
    WAIT_BAR(0);
    DMA_K(3, s0); DMA_V(1, s1);
    ROT();
    KLOAD2(sl_cur, 0); KLOAD2(sl_cur, 1); KLOAD2(sl_cur, 2); KLOAD2(sl_cur, 3); KLOAD2(sl_cur, 4); KLOAD2(sl_cur, 5);
    WAIT_BAR(3);
    bf16x8 qfa = *(const __attribute__((address_space(3))) bf16x8*)(qsp), qfb;
    s16x4 vlo[8], vhi[8]; u32x4 pw0, pw1, pw2, pw3;
#define PKW(P, B) pk2(P[B], P[(B) + 1])
#define PAF(k) __builtin_bit_cast(bf16x8, pw##k)
#define VFR(i) (bf16x8){vlo[i][0], vlo[i][1], vlo[i][2], vlo[i][3], vhi[i][0], vhi[i][1], vhi[i][2], vhi[i][3]}
#define PIN(x) asm volatile("" : "+v"(x))
#define EX(v) __builtin_amdgcn_exp2f(v)
#define VRD(i) do { vlo[i] = vtr(vp_ + (((i) >> 2) * 4096 + ((i) & 3) * 1024)); vhi[i] = vtr(vp_ + (((i) >> 2) * 4096 + ((i) & 3) * 1024 + 512)); } while (0)
#define QK(Cx, kk, qv, first) Cx = __builtin_amdgcn_mfma_f32_32x32x16_bf16(kf[kk], qv, (first) ? negm : Cx, 0, 0, 0)
#define QLD(dst, s) dst = *(const __attribute__((address_space(3))) bf16x8*)(qsp + (s) * 1024)
#define GAPA3(RD, MF, A0, A1, A2, PK_STMT) do { RD; SBAR(); MF; sacc += A0; sacc += A1; sacc += A2; PIN(sacc); PK_STMT; SBAR(); } while (0)
#define GAPB(KR, MF, X, B) do { KR; MF; X[B] = EX(X[B]); X[(B) + 1] = EX(X[(B) + 1]); X[(B) + 2] = EX(X[(B) + 2]); X[(B) + 3] = EX(X[(B) + 3]); PIN(X); SBAR(); } while (0)
#define STEP(C0, C1, P0, P1, t, GK, GV, GL, BAND) do { SBAR(); \
    const lds_cptr vp_ = vp0 + sl_prev * VSLOT; \
    float sacc = (P0[0] + P0[1]); \
    GAPA3(QLD(qfb, 1), QK(C0, 0, qfa, true),   P0[2],  P0[3],  P0[4],  pw0[0] = PKW(P0, 0); pw0[1] = PKW(P0, 2); PIN(pw0)); \
    GAPA3((void)0, QK(C1, 1, qfa, true),   P0[5],  P0[6],  P0[7],  pw0[2] = PKW(P0, 4); pw0[3] = PKW(P0, 6); PIN(pw0)); \
    GAPA3(QLD(qfa, 2), QK(C0, 2, qfb, false),  P0[8],  P0[9],  P0[10], pw1[0] = PKW(P0, 8); pw1[1] = PKW(P0, 10); PIN(pw1)); \
    GAPA3((void)0, QK(C1, 3, qfb, false),  P0[11], P0[12], P0[13], pw1[2] = PKW(P0, 12); pw1[3] = PKW(P0, 14); PIN(pw1)); \
    GAPA3(QLD(qfb, 3), QK(C0, 4, qfa, false),  P0[14], P0[15], P1[0],  pw2[0] = PKW(P1, 0); PIN(pw2)); \
    GAPA3((void)0, QK(C1, 5, qfa, false),  P1[1],  P1[2],  P1[3],  pw2[1] = PKW(P1, 2); PIN(pw2)); \
    GAPA3(QLD(qfa, 4), QK(C0, 6, qfb, false),  P1[4],  P1[5],  P1[6],  pw2[2] = PKW(P1, 4); PIN(pw2)); \
    GAPA3((void)0, QK(C1, 7, qfb, false),  P1[7],  P1[8],  P1[9],  pw2[3] = PKW(P1, 6); PIN(pw2)); \
    GAPA3({ QLD(qfb, 5); VRD(0); }, QK(C0, 8, qfa, false), P1[10], P1[11], P1[12], pw3[0] = PKW(P1, 8); PIN(pw3)); \
    GAPA3(VRD(1), QK(C1, 9, qfa, false), P1[13], P1[14], P1[15], pw3[1] = PKW(P1, 10); PIN(pw3)); \
    GAPA3(VRD(2), QK(C0, 10, qfb, false), 0.f, 0.f, 0.f,         pw3[2] = PKW(P1, 12); PIN(pw3)); \
    GAPA3(VRD(3), QK(C1, 11, qfb, false), 0.f, 0.f, 0.f,         pw3[3] = PKW(P1, 14); PIN(pw3)); \
    l_reg += sacc; \
    if (GK) { DMA_K((t) + 3, sl_cur); } if (GV) { DMA_V((t) + 1, sl_next); } \
    if (BAND) { const int jb_ = (t) - (NT - 4); if (jb_ >= 0) cmask(C0, C1, jb_, qrel, hi); } \
    { const float rm = rowmax(C0, C1); \
      resc = false; \
      if (__builtin_expect(__any(rm > (float)THRL), 0)) { const float dl = __builtin_fmaxf(rm, 0.f); mhat += dl; \
        _Pragma("unroll") for (int r = 0; r < 16; ++r) { C0[r] -= dl; C1[r] -= dl; } \
        _Pragma("unroll") for (int r = 0; r < 16; ++r) negm[r] = -mhat; asm volatile("" : "+v"(negm)); \
        const float f = __builtin_amdgcn_exp2f(-dl); l_reg *= f; if (hi == 0) wsf[r32] = f; resc = true; } } \
    SBAR(); \
    GAPB({ VRD(4); SBAR(); },                                    o[0] = __builtin_amdgcn_mfma_f32_32x32x16_bf16(PAF(0), VFR(0), o[0], 0, 0, 0), C0, 0); \
    GAPB({ if (GL) { KLOAD2(sl_next, 0); } VRD(5); SBAR(); },     o[0] = __builtin_amdgcn_mfma_f32_32x32x16_bf16(PAF(1), VFR(1), o[0], 0, 0, 0), C0, 4); \
    GAPB({ if (GL) { KLOAD2(sl_next, 1); } VRD(6); SBAR(); },     o[0] = __builtin_amdgcn_mfma_f32_32x32x16_bf16(PAF(2), VFR(2), o[0], 0, 0, 0), C0, 8); \
    GAPB({ if (GL) { KLOAD2(sl_next, 2); } VRD(7); SBAR(); },     o[0] = __builtin_amdgcn_mfma_f32_32x32x16_bf16(PAF(3), VFR(3), o[0], 0, 0, 0), C0, 12); \
    GAPB({ if (GL) { KLOAD2(sl_next, 3); SBAR(); } },             o[1] = __builtin_amdgcn_mfma_f32_32x32x16_bf16(PAF(0), VFR(4), o[1], 0, 0, 0), C1, 0); \
    GAPB({ if (GL) { KLOAD2(sl_next, 4); SBAR(); } },             o[1] = __builtin_amdgcn_mfma_f32_32x32x16_bf16(PAF(1), VFR(5), o[1], 0, 0, 0), C1, 4); \
    GAPB({ if (GL) { KLOAD2(sl_next, 5); SBAR(); } },             o[1] = __builtin_amdgcn_mfma_f32_32x32x16_bf16(PAF(2), VFR(6), o[1], 0, 0, 0), C1, 8); \
    GAPB({ QLD(qfa, 0); SBAR(); },                                 o[1] = __builtin_amdgcn_mfma_f32_32x32x16_bf16(PAF(3), VFR(7), o[1], 0, 0, 0), C1, 12); \
    } while (0)
    int t = 1;
    for (; t + 5 < NT; t += 2) {
        STEP(pB0, pB1, pA0, pA1, t, true, true, true, false);       WAIT_BAR(3); RESC(); ROT();
        STEP(pA0, pA1, pB0, pB1, t + 1, true, true, true, false);   WAIT_BAR(3); RESC(); ROT();
    }
#define ENDW(tt) do { if ((tt) + 3 < NT) { WAIT_BAR(3); } else if ((tt) + 2 < NT) { WAIT_BAR(1); } else { WAIT_BAR(0); } } while (0)
    for (; t + 1 < NT; t += 2) {
        STEP(pB0, pB1, pA0, pA1, t, (t + 3 < NT), (t + 1 < NT), (t + 1 < NT), true);           ENDW(t);     RESC(); ROT();
        STEP(pA0, pA1, pB0, pB1, t + 1, (t + 4 < NT), (t + 2 < NT), (t + 2 < NT), true);       ENDW(t + 1); RESC(); ROT();
    }
    if (has_next) { const int n0 = sl_next, n1 = (n0 == 2) ? 0 : n0 + 1, n2 = (n1 == 2) ? 0 : n1 + 1; DMA_K(0, n0); DMA_V(0, n0); DMA_K(1, n1); DMA_K(2, n2); }
    s0 = sl_next;
    STEP(pB0, pB1, pA0, pA1, NT - 1, false, false, false, true); RESC();
    bf16x8 qn[6];
    if (has_next) { const bf16_t* Qn = Q + (rowbase + nqb * 256 + wid * 32 + r32) * 1536 + h * 96 + hi * 8;
#pragma unroll
        for (int s = 0; s < 6; ++s) qn[s] = *(const bf16x8*)(Qn + s * 16); }
    { float sacc = pB0[0] + pB0[1];
#pragma unroll
      for (int r = 2; r < 16; ++r) sacc += pB0[r];
#pragma unroll
      for (int r = 0; r < 16; ++r) sacc += pB1[r];
      l_reg += sacc;
      pw0 = (u32x4){PKW(pB0, 0), PKW(pB0, 2), PKW(pB0, 4), PKW(pB0, 6)}; pw1 = (u32x4){PKW(pB0, 8), PKW(pB0, 10), PKW(pB0, 12), PKW(pB0, 14)};
      pw2 = (u32x4){PKW(pB1, 0), PKW(pB1, 2), PKW(pB1, 4), PKW(pB1, 6)}; pw3 = (u32x4){PKW(pB1, 8), PKW(pB1, 10), PKW(pB1, 12), PKW(pB1, 14)};
      SBAR();
      const lds_cptr vp_ = vp0 + sl_cur * VSLOT;
#pragma unroll
      for (int d0 = 0; d0 < 2; ++d0) {
#pragma unroll
          for (int i = 0; i < 4; ++i) VRD(4 * d0 + i);
      }
      o[0] = __builtin_amdgcn_mfma_f32_32x32x16_bf16(PAF(0), VFR(0), o[0], 0, 0, 0); o[0] = __builtin_amdgcn_mfma_f32_32x32x16_bf16(PAF(1), VFR(1), o[0], 0, 0, 0);
      o[0] = __builtin_amdgcn_mfma_f32_32x32x16_bf16(PAF(2), VFR(2), o[0], 0, 0, 0); o[0] = __builtin_amdgcn_mfma_f32_32x32x16_bf16(PAF(3), VFR(3), o[0], 0, 0, 0);
      o[1] = __builtin_amdgcn_mfma_f32_32x32x16_bf16(PAF(0), VFR(4), o[1], 0, 0, 0); o[1] = __builtin_amdgcn_mfma_f32_32x32x16_bf16(PAF(1), VFR(5), o[1], 0, 0, 0);
      o[1] = __builtin_amdgcn_mfma_f32_32x32x16_bf16(PAF(2), VFR(6), o[1], 0, 0, 0); o[1] = __builtin_amdgcn_mfma_f32_32x32x16_bf16(PAF(3), VFR(7), o[1], 0, 0, 0); }
    bf16_t* Gw = G + (rowbase + q0 + wid * 32) * 1024 + h * 64;
    u32x4 gvv[4];
#pragma unroll
    for (int i = 0; i < 4; ++i) gvv[i] = *(const u32x4*)(Gw + (long)(i * 8 + (lane >> 3)) * 1024 + (lane & 7) * 8);
    { auto rr = __builtin_amdgcn_permlane32_swap(__float_as_uint(l_reg), __float_as_uint(l_reg), false, false); l_reg = __uint_as_float(rr[0]) + __uint_as_float(rr[1]); }
    if (hi == 0) wsf[32 + r32] = l_reg;
    asm volatile("s_waitcnt lgkmcnt(0)" ::: "memory");
    { bf16_t* stg = (bf16_t*)(shm + L_OST) + wid * 2048;
#pragma unroll
      for (int r = 0; r < 16; ++r) { const int orow = crow(r, hi); const float rl = __builtin_amdgcn_rcpf(wsf[32 + orow]);
          stg[orow * 64 + r32] = (bf16_t)(pk2(o[0][r] * rl, 0.f) & 0xffffu); stg[orow * 64 + 32 + r32] = (bf16_t)(pk2(o[1][r] * rl, 0.f) & 0xffffu); }
      asm volatile("s_waitcnt lgkmcnt(0)" ::: "memory");
#pragma unroll
      for (int i = 0; i < 4; ++i) { const int row = i * 8 + (lane >> 3), ch = lane & 7;
          const u32x4 ov = *(const u32x4*)(stg + row * 64 + ch * 8);
          bf16_t* gp = Gw + (long)row * 1024 + ch * 8;
          const u32x4 gv = gvv[i]; u32x4 w;
#pragma unroll
          for (int e = 0; e < 4; ++e) w[e] = pk2(bflo(ov[e]) * bflo(gv[e]), bfhi(ov[e]) * bfhi(gv[e]));
          if (DRY) asm volatile("" :: "v"(w)); else *(u32x4*)gp = w; } }
    if (has_next) {
#pragma unroll
        for (int s = 0; s < 6; ++s) *(__attribute__((address_space(3))) bf16x8*)(qsp + s * 1024) = qn[s];
    }
    asm volatile("s_waitcnt lgkmcnt(0)\n\ts_barrier" ::: "memory");
#undef DMA_K
#undef DMA_V
#undef KLOAD2
#undef RESC
#undef ROT
#undef PKW
#undef PAF
#undef VFR
#undef PIN
#undef EX
#undef VRD
#undef QK
#undef QLD
#undef GAPA3
#undef GAPB
#undef STEP
#undef ENDW
}
#undef SBAR
#undef WAIT_BAR
#undef MX3
template <bool DRY>
__device__ __forceinline__ void phase(char* lds, const bf16_t* Q, const bf16_t* K, const bf16_t* KPE, const bf16_t* V, bf16_t* G, int vcu, int ncu, int wid) {
    for (int v = vcu; v < 256; v += ncu) {
        const int bh = v >> 2, s = v & 3;
        int s0 = 0;
#pragma unroll 1
        for (int i = 0; i < 4; ++i) { const int qb = (i == 0) ? s : (i == 1) ? 7 - s : (i == 2) ? 8 + s : 15 - s; const int nqb = (i == 0) ? 7 - s : (i == 1) ? 8 + s : 15 - s;
            unit<DRY>(bh >> 4, bh & 15, qb, Q, K, KPE, V, G, lds, wid, s0, i > 0, i < 3, nqb); }
        asm volatile("s_waitcnt vmcnt(0)" ::: "memory");
    }
}
}

namespace band {
constexpr int LW = 18176;
__device__ __forceinline__ int crow(int r, int hi) { return (r & 3) + 8 * (r >> 2) + 4 * hi; }
template <int OFF> __device__ __forceinline__ s16x4 tr_read(int vb) {
    s16x4 r; asm volatile("ds_read_b64_tr_b16 %0, %1 offset:%2" : "=&v"(r) : "v"(vb), "i"(OFF) : "memory"); return r;
}
struct BandPre { float tv[3]; bf16x8 qf[4]; bf16x8 k0[4]; };
__device__ __forceinline__ void item_prefetch(BandPre& P, const bf16_t* __restrict__ QKV, int b, int qcol, int kcol, int vcol, int dil, int res, int i0, const float* __restrict__ tabg) {
    const int lane = lane_id(), r32 = lane & 31, hi = lane >> 5;
    const long rowpitch = (long)dil * QKV_W;
    const bf16_t* base = QKV + ((long)b * S + res) * QKV_W;
#pragma unroll
    for (int i = 0; i < 3; ++i) { const int j = 190 - (lane + 64 * i); P.tv[i] = (j >= 0) ? tabg[j] : -INFINITY; }
    { const bf16_t* qp = base + (long)(i0 + r32) * rowpitch + qcol + 8 * hi;
#pragma unroll
      for (int s = 0; s < 4; ++s) P.qf[s] = *(const bf16x8*)(qp + 16 * s); }
    const int jk = (i0 >= 128) ? (i0 - 128) : i0;
    const char* sb = (const char*)base + (long)jk * rowpitch * 2 + (long)(kcol - vcol) * 2;
#pragma unroll
    for (int i = 0; i < 4; ++i) P.k0[i] = *(const bf16x8*)(sb + (unsigned)(((8 * i + (lane >> 3)) * (int)rowpitch + vcol + (lane & 7) * 8) * 2));
}
template <int MODE, bool DRY>
__device__ __forceinline__ void item(BandPre& P, const bf16_t* __restrict__ QKV, int b, int qcol, int kcol, int vcol, int dil, int res, int i0, float sink2,
                                     bf16_t* outp, long out_pitch, float* lsep, int lse_pitch, LAS unsigned char* wl,
                                     bool has_next, int n_b, int n_qcol, int n_kcol, int n_vcol, int n_dil, int n_res, int n_i0, const float* __restrict__ n_tabg) {
    const int lane = lane_id();
    const int r32 = lane & 31, hi = lane >> 5;
    const long rowpitch = (long)dil * QKV_W;
    const bf16_t* base = QKV + ((long)b * S + res) * QKV_W;
    LAS unsigned char* kl = wl + 8192;
    LAS float* tab = (LAS float*)(wl + 16384);
    LAS float* scr = (LAS float*)(wl + 16384 + 1536);
    float tv[3]; bf16x8 qf[4];
#pragma unroll
    for (int i = 0; i < 3; ++i) tv[i] = P.tv[i];
#pragma unroll
    for (int s = 0; s < 4; ++s) qf[s] = P.qf[s];
    const int kmin = (i0 >= 128) ? 0 : 4 - (i0 >> 5);
    bf16x8 kr[5][4], vr[5][4];
#pragma unroll
    for (int i = 0; i < 4; ++i) kr[0][i] = P.k0[i];
    unsigned voff[4];
#pragma unroll
    for (int i = 0; i < 4; ++i) voff[i] = (unsigned)(((8 * i + (lane >> 3)) * (int)rowpitch + vcol + (lane & 7) * 8) * 2);
    const long kdelta = (long)(kcol - vcol) * 2;
#pragma unroll
    for (int k = 1; k < 5; ++k) {
        const int jk = (k >= kmin) ? (i0 - 128 + 32 * k) : i0;
        const char* sb = (const char*)base + (long)jk * rowpitch * 2;
#pragma unroll
        for (int i = 0; i < 4; ++i) kr[k][i] = *(const bf16x8*)(sb + kdelta + voff[i]);
    }
#pragma unroll
    for (int k = 0; k < 5; ++k) {
        const int jk = (k >= kmin) ? (i0 - 128 + 32 * k) : i0;
        const char* sb = (const char*)base + (long)jk * rowpitch * 2;
#pragma unroll
        for (int i = 0; i < 4; ++i) vr[k][i] = *(const bf16x8*)(sb + voff[i]);
    }
    const int vst = ((lane & 7) >> 2) * 2048 + (lane >> 3) * 64 + (lane & 3) * 16;
    const int vb = (int)(uintptr_t)wl + (4 * hi + ((lane & 15) >> 2)) * 64 + ((lane >> 4) & 1) * 32 + (lane & 3) * 8;
    const int kst = (lane >> 3) * 128 + (((lane & 7) ^ ((lane >> 3) & 7)) << 4);
#pragma unroll
    for (int i = 0; i < 3; ++i) { tab[lane + 64 * i] = tv[i]; tab[192 + lane + 64 * i] = -INFINITY; }
    f32x16 p[5];
#pragma unroll
    for (int k = 0; k < 5; ++k) {
        LAS unsigned char* kb = kl + (k & 1) * 4096;
#pragma unroll
        for (int i = 0; i < 4; ++i) *(LAS bf16x8*)(kb + kst + i * 1024) = kr[k][i];
        const LAS float* tk = tab + ((k >= kmin) ? 0 : 192) + (31 - r32 + 32 * k);
        f32x16 acc;
#pragma unroll
        for (int r = 0; r < 16; ++r) acc[r] = tk[crow(r, hi)];
        bf16x8 ka[4];
#pragma unroll
        for (int s2 = 0; s2 < 4; ++s2) ka[s2] = *(const LAS bf16x8*)(kb + r32 * 128 + (((2 * s2 + hi) ^ (r32 & 7)) << 4));
        asm volatile("s_waitcnt lgkmcnt(0)" : "+v"(acc), "+v"(ka[0]), "+v"(ka[1]), "+v"(ka[2]), "+v"(ka[3]) :: "memory");
#pragma unroll
        for (int s2 = 0; s2 < 4; ++s2) acc = __builtin_amdgcn_mfma_f32_32x32x16_bf16(ka[s2], qf[s2], acc, 0, 0, 0);
        p[k] = acc;
    }
    u32x4 gv[4];
    if (MODE == 0) {
#pragma unroll
        for (int i = 0; i < 4; ++i) gv[i] = *(const u32x4*)(outp + (long)(i * 8 + (lane >> 3)) * out_pitch + (lane & 7) * 8);
    }
    float m = p[0][0];
#pragma unroll
    for (int k = 0; k < 5; ++k)
#pragma unroll
        for (int r = 0; r < 16; ++r) m = fmaxf(m, p[k][r]);
    { auto rr = __builtin_amdgcn_permlane32_swap(__float_as_uint(m), __float_as_uint(m), false, false); m = fmaxf(__uint_as_float(rr[0]), __uint_as_float(rr[1])); }
    if (MODE == 0) m = fmaxf(m, sink2);
    float l = 0.f;
#pragma unroll
    for (int k = 0; k < 5; ++k)
#pragma unroll
        for (int r = 0; r < 16; ++r) { p[k][r] = __builtin_amdgcn_exp2f(p[k][r] - m); l += p[k][r]; }
    { auto rr = __builtin_amdgcn_permlane32_swap(__float_as_uint(l), __float_as_uint(l), false, false); l = __uint_as_float(rr[0]) + __uint_as_float(rr[1]); }
    if (MODE == 0) l += __builtin_amdgcn_exp2f(sink2 - m);
    bf16x8 pa[5][2];
#pragma unroll
    for (int k = 0; k < 5; ++k) {
        u32x4 w;
        w.x = pk2(p[k][0], p[k][1]); w.y = pk2(p[k][2], p[k][3]); w.z = pk2(p[k][4], p[k][5]); w.w = pk2(p[k][6], p[k][7]); pa[k][0] = __builtin_bit_cast(bf16x8, w);
        w.x = pk2(p[k][8], p[k][9]); w.y = pk2(p[k][10], p[k][11]); w.z = pk2(p[k][12], p[k][13]); w.w = pk2(p[k][14], p[k][15]); pa[k][1] = __builtin_bit_cast(bf16x8, w);
    }
    if (has_next) item_prefetch(P, QKV, n_b, n_qcol, n_kcol, n_vcol, n_dil, n_res, n_i0, n_tabg);
    f32x16 o[2]; o[0] = f32x16{}; o[1] = f32x16{};
#pragma unroll
    for (int k = 0; k < 5; ++k) {
        const bf16x8 pa0 = pa[k][0], pa1 = pa[k][1];
        LAS unsigned char* vbuf = wl + (k & 1) * 4096;
#pragma unroll
        for (int i = 0; i < 4; ++i) *(LAS bf16x8*)(vbuf + vst + i * 512) = vr[k][i];
        asm volatile("s_waitcnt lgkmcnt(0)" ::: "memory");
        const int vbk = vb + (k & 1) * 4096;
        const s16x4 a0 = tr_read<0>(vbk), a1 = tr_read<512>(vbk), a2 = tr_read<1024>(vbk), a3 = tr_read<1536>(vbk);
        const s16x4 c0 = tr_read<2048>(vbk), c1 = tr_read<2048 + 512>(vbk), c2 = tr_read<2048 + 1024>(vbk), c3 = tr_read<2048 + 1536>(vbk);
        asm volatile("s_waitcnt lgkmcnt(0)" ::: "memory"); __builtin_amdgcn_sched_barrier(0);
#define PKV(L, H) (bf16x8){L[0], L[1], L[2], L[3], H[0], H[1], H[2], H[3]}
        o[0] = __builtin_amdgcn_mfma_f32_32x32x16_bf16(PKV(a0, a1), pa0, o[0], 0, 0, 0);
        o[0] = __builtin_amdgcn_mfma_f32_32x32x16_bf16(PKV(a2, a3), pa1, o[0], 0, 0, 0);
        o[1] = __builtin_amdgcn_mfma_f32_32x32x16_bf16(PKV(c0, c1), pa0, o[1], 0, 0, 0);
        o[1] = __builtin_amdgcn_mfma_f32_32x32x16_bf16(PKV(c2, c3), pa1, o[1], 0, 0, 0);
#undef PKV
    }
    const float rl = __builtin_amdgcn_rcpf(l);
    LAS unsigned char* stg = wl;
#pragma unroll
    for (int d0 = 0; d0 < 2; ++d0)
#pragma unroll
        for (int g = 0; g < 4; ++g) {
            u32x2 w; w.x = pk2(o[d0][4 * g] * rl, o[d0][4 * g + 1] * rl); w.y = pk2(o[d0][4 * g + 2] * rl, o[d0][4 * g + 3] * rl);
            *(LAS u32x2*)(stg + r32 * 144 + (32 * d0 + 8 * g + 4 * hi) * 2) = w;
        }
    asm volatile("s_waitcnt lgkmcnt(0)" ::: "memory");
#pragma unroll
    for (int i = 0; i < 4; ++i) {
        const int row = i * 8 + (lane >> 3), ch = lane & 7;
        const u32x4 ov = *(const LAS u32x4*)(stg + row * 144 + ch * 16);
        bf16_t* gp = outp + (long)row * out_pitch + ch * 8;
        if (MODE == 0) {
            u32x4 w;
#pragma unroll
            for (int e = 0; e < 4; ++e) w[e] = pk2(bflo(ov[e]) * bflo(gv[i][e]), bfhi(ov[e]) * bfhi(gv[i][e]));
            if (DRY) asm volatile("" :: "v"(w)); else *(u32x4*)gp = w;
        } else { if (DRY) asm volatile("" :: "v"(ov)); else *(u32x4*)gp = ov; }
    }
    if (MODE == 1 && !DRY) { if (hi == 0) lsep[(long)r32 * lse_pitch] = m + __builtin_amdgcn_logf(l); }
    asm volatile("s_waitcnt lgkmcnt(0)" ::: "memory");
}

template <bool DRY>
__device__ __forceinline__ void phase(LAS unsigned char* lds, const bf16_t* QKV, bf16_t* G, bf16_t* OC, float* LSE, const float* BT, const float* sinks, int vcu, int ncu, int wave, int lane) {
    LAS unsigned char* wl = lds + wave * LW;
    for (int u = vcu; u < 256; u += ncu) {
        const int b = u >> 6, h = (u >> 3) & 7, t0 = (u & 7) * 512;
#define B_ITEM_PARAMS(it_, dil_, res_, i0_, cfg_) const int cfg_ = (it_) >> 4, w_##cfg_ = (it_) & 15; const int dil_ = (cfg_ == 0) ? 1 : (cfg_ == 1) ? 4 : 16; \
            const int res_ = (cfg_ == 0) ? 0 : (cfg_ == 1) ? (w_##cfg_ & 3) : w_##cfg_; const int i0_ = t0 / dil_ + 32 * ((cfg_ == 0) ? w_##cfg_ : (cfg_ == 1) ? (w_##cfg_ >> 2) : 0)
        BandPre P;
        { B_ITEM_PARAMS(wave, dil, res, i0, cfg); item_prefetch(P, QKV, b, 768 + h * 64, 1280 + h * 64, 1792 + h * 64, dil, res, i0, BT + ((1 + cfg) * 8 + h) * 192); }
#define A_ITEM_PARAMS(ia_, g32_, ha_, ba_) const int id_##g32_ = u * 16 + (ia_), g32_ = id_##g32_ & 127, ha_ = (id_##g32_ >> 7) & 7, ba_ = id_##g32_ >> 10
#pragma unroll 1
        for (int it = wave; it < 48; it += 8) {
            B_ITEM_PARAMS(it, dil, res, i0, cfg);
            const bool nb_ = (it + 8 < 48);
            const int itn = nb_ ? it + 8 : it;
            B_ITEM_PARAMS(itn, ndil, nres, ni0, ncfg);
            A_ITEM_PARAMS(wave, ag32, aha, aba);
            const long tok0 = (long)b * S + res + (long)dil * i0;
            item<1, false>(P, QKV, b, 768 + h * 64, 1280 + h * 64, 1792 + h * 64, dil, res, i0, 0.f,
                    OC + (size_t)cfg * T * 512 + tok0 * 512 + h * 64, (long)dil * 512, LSE + (size_t)cfg * T * 8 + tok0 * 8 + h, dil * 8, wl,
                    true, nb_ ? b : aba, nb_ ? 768 + h * 64 : aha * 64, nb_ ? 1280 + h * 64 : 512 + (aha >> 2) * 64, nb_ ? 1792 + h * 64 : 640 + (aha >> 2) * 64,
                    nb_ ? ndil : 1, nb_ ? nres : 0, nb_ ? ni0 : ag32 * 32, nb_ ? BT + ((1 + ncfg) * 8 + h) * 192 : BT + aha * 192);
        }
#pragma unroll 1
        for (int ia = wave; ia < 16; ia += 8) {
            A_ITEM_PARAMS(ia, g32, ha, ba);
            const int ian = (ia + 8 < 16) ? ia + 8 : ia;
            A_ITEM_PARAMS(ian, ng32, nha, nba);
            const int kvh = ha >> 2, i0 = g32 * 32;
            item<0, DRY>(P, QKV, ba, ha * 64, 512 + kvh * 64, 640 + kvh * 64, 1, 0, i0, sinks[ha] * LOG2E,
                    G + ((long)ba * S + i0) * 1024 + ha * 64, 1024, nullptr, 0, wl,
                    ia + 8 < 16, nba, nha * 64, 512 + (nha >> 2) * 64, 640 + (nha >> 2) * 64, 1, 0, ng32 * 32, BT + nha * 192);
        }
        asm volatile("s_waitcnt vmcnt(0)" ::: "memory");
        __syncthreads();
        {
            const int tid = wave * 64 + lane_id();
#pragma unroll 1
            for (int i0 = 0; i0 < 8; i0 += 4) {
                float lse_[4][3]; u32x4 oc_[4][3], gv_[4];
#pragma unroll
                for (int j = 0; j < 4; ++j) {
                    const int e = tid + 512 * (i0 + j), tau = e >> 3, ch = e & 7;
                    const long tok = (long)b * S + t0 + tau;
#pragma unroll
                    for (int c = 0; c < 3; ++c) { lse_[j][c] = LSE[(size_t)c * T * 8 + tok * 8 + h]; oc_[j][c] = *(const u32x4*)(OC + (size_t)c * T * 512 + tok * 512 + h * 64 + ch * 8); }
                    gv_[j] = *(const u32x4*)(G + tok * 1024 + 512 + h * 64 + ch * 8);
                }
                asm volatile("" ::: "memory");
#pragma unroll
                for (int j = 0; j < 4; ++j) {
                    const int e = tid + 512 * (i0 + j), tau = e >> 3, ch = e & 7;
                    const long tok = (long)b * S + t0 + tau;
                    const float mx = fmaxf(lse_[j][0], fmaxf(lse_[j][1], lse_[j][2]));
                    float w0 = __builtin_amdgcn_exp2f(lse_[j][0] - mx), w1 = __builtin_amdgcn_exp2f(lse_[j][1] - mx), w2 = __builtin_amdgcn_exp2f(lse_[j][2] - mx);
                    const float rs = 1.f / (w0 + w1 + w2); w0 *= rs; w1 *= rs; w2 *= rs;
                    u32x4 wv;
#pragma unroll
                    for (int q = 0; q < 4; ++q) {
                        const float lo = w0 * bflo(oc_[j][0][q]) + w1 * bflo(oc_[j][1][q]) + w2 * bflo(oc_[j][2][q]), hv = w0 * bfhi(oc_[j][0][q]) + w1 * bfhi(oc_[j][1][q]) + w2 * bfhi(oc_[j][2][q]);
                        wv[q] = pk2(lo * bflo(gv_[j][q]), hv * bfhi(gv_[j][q]));
                    }
                    bf16_t* gp = G + tok * 1024 + 512 + h * 64 + ch * 8;
                    if (DRY) asm volatile("" :: "v"(wv)); else *(u32x4*)gp = wv;
                }
            }
        }
        __syncthreads();
    }
}
}

__global__ __launch_bounds__(256) void naive_ab_attn(const bf16_t* __restrict__ QKV, bf16_t* G, const float* __restrict__ BT, const float* __restrict__ sinks) {
    for (long idx = (long)blockIdx.x * 256 + threadIdx.x; idx < (long)T * 16; idx += (long)gridDim.x * 256) {
        const int hh = (int)(idx / T), t = (int)(idx % T), b = t / S, s = t % S;
        int qoff, koff, voff, ncfg, cfg0, h;
        if (hh < 8) { h = hh; qoff = h * 64; koff = 512 + (h >> 2) * 64; voff = 640 + (h >> 2) * 64; ncfg = 1; cfg0 = 0; }
        else { h = hh - 8; qoff = 768 + h * 64; koff = 1280 + h * 64; voff = 1792 + h * 64; ncfg = 3; cfg0 = 1; }
        bf16x8 q[8];
#pragma unroll
        for (int i = 0; i < 8; ++i) q[i] = *(const bf16x8*)(QKV + (size_t)t * QKV_W + qoff + 8 * i);
        float mx = (hh < 8) ? sinks[h] * LOG2E : -INFINITY;
        for (int c = 0; c < ncfg; ++c) {
            const int dil = (c == 0) ? 1 : ((c == 1) ? 4 : 16);
            const float* bt = BT + ((cfg0 + c) * 8 + h) * 192 + 31;
            for (int dl = 0; dl <= 128; ++dl) {
                const int j = s - dil * dl; if (j < 0) break;
                const bf16_t* kr = QKV + (size_t)(b * S + j) * QKV_W + koff;
                float sc = 0.f;
#pragma unroll
                for (int i = 0; i < 8; ++i) sc = dot8(q[i], *(const bf16x8*)(kr + 8 * i), sc);
                mx = fmaxf(mx, sc + bt[dl]);
            }
        }
        float l = (hh < 8) ? exp2f(sinks[h] * LOG2E - mx) : 0.f;
        float o[64];
#pragma unroll
        for (int d = 0; d < 64; ++d) o[d] = 0.f;
        for (int c = 0; c < ncfg; ++c) {
            const int dil = (c == 0) ? 1 : ((c == 1) ? 4 : 16);
            const float* bt = BT + ((cfg0 + c) * 8 + h) * 192 + 31;
            for (int dl = 0; dl <= 128; ++dl) {
                const int j = s - dil * dl; if (j < 0) break;
                const bf16_t* kr = QKV + (size_t)(b * S + j) * QKV_W + koff;
                const bf16_t* vr = QKV + (size_t)(b * S + j) * QKV_W + voff;
                float sc = 0.f;
#pragma unroll
                for (int i = 0; i < 8; ++i) sc = dot8(q[i], *(const bf16x8*)(kr + 8 * i), sc);
                const float p = exp2f(sc + bt[dl] - mx);
                l += p;
#pragma unroll
                for (int i = 0; i < 8; ++i) {
                    const u32x4 vv = __builtin_bit_cast(u32x4, *(const bf16x8*)(vr + 8 * i));
#pragma unroll
                    for (int e = 0; e < 4; ++e) { o[8 * i + 2 * e] = fmaf(p, bflo(vv[e]), o[8 * i + 2 * e]); o[8 * i + 2 * e + 1] = fmaf(p, bfhi(vv[e]), o[8 * i + 2 * e + 1]); }
                }
            }
        }
        const float rl = 1.f / l;
        bf16_t* gp = G + (size_t)t * DM + hh * 64;
#pragma unroll
        for (int i = 0; i < 8; ++i) {
            const u32x4 gv = *(const u32x4*)(gp + 8 * i); u32x4 w;
#pragma unroll
            for (int e = 0; e < 4; ++e) w[e] = pk2(o[8 * i + 2 * e] * rl * bflo(gv[e]), o[8 * i + 2 * e + 1] * rl * bfhi(gv[e]));
            *(u32x4*)(gp + 8 * i) = w;
        }
    }
}

__global__ __launch_bounds__(256) void naive_mla_attn(const bf16_t* __restrict__ Q, const bf16_t* __restrict__ K, const bf16_t* __restrict__ KPE, const bf16_t* __restrict__ V, bf16_t* G) {
    for (long idx = (long)blockIdx.x * 256 + threadIdx.x; idx < (long)T * 16; idx += (long)gridDim.x * 256) {
        const int h = (int)(idx / T), t = (int)(idx % T), b = t / S, s = t % S;
        bf16x8 q[12];
#pragma unroll
        for (int i = 0; i < 12; ++i) q[i] = *(const bf16x8*)(Q + (size_t)t * 1536 + h * 96 + 8 * i);
        float mx = -INFINITY, l = 0.f;
        float o[64];
#pragma unroll
        for (int d = 0; d < 64; ++d) o[d] = 0.f;
        for (int j = 0; j <= s; ++j) {
            const bf16_t* kr = K + (size_t)(b * S + j) * 1024 + h * 64;
            const bf16_t* pr = KPE + (size_t)(b * S + j) * 32;
            const bf16_t* vr = V + (size_t)(b * S + j) * 1024 + h * 64;
            float sc = 0.f;
#pragma unroll
            for (int i = 0; i < 8; ++i) sc = dot8(q[i], *(const bf16x8*)(kr + 8 * i), sc);
#pragma unroll
            for (int i = 0; i < 4; ++i) sc = dot8(q[8 + i], *(const bf16x8*)(pr + 8 * i), sc);
            if (sc > mx) {
                const float f = exp2f(mx - sc); l *= f;
#pragma unroll
                for (int d = 0; d < 64; ++d) o[d] *= f;
                mx = sc;
            }
            const float p = exp2f(sc - mx);
            l += p;
#pragma unroll
            for (int i = 0; i < 8; ++i) {
                const u32x4 vv = __builtin_bit_cast(u32x4, *(const bf16x8*)(vr + 8 * i));
#pragma unroll
                for (int e = 0; e < 4; ++e) { o[8 * i + 2 * e] = fmaf(p, bflo(vv[e]), o[8 * i + 2 * e]); o[8 * i + 2 * e + 1] = fmaf(p, bfhi(vv[e]), o[8 * i + 2 * e + 1]); }
            }
        }
        const float rl = 1.f / l;
        bf16_t* gp = G + (size_t)t * DM + h * 64;
#pragma unroll
        for (int i = 0; i < 8; ++i) {
            const u32x4 gv = *(const u32x4*)(gp + 8 * i); u32x4 w;
#pragma unroll
            for (int e = 0; e < 4; ++e) w[e] = pk2(o[8 * i + 2 * e] * rl * bflo(gv[e]), o[8 * i + 2 * e + 1] * rl * bfhi(gv[e]));
            *(u32x4*)(gp + 8 * i) = w;
        }
    }
}

#define XB_TMO      128
#define XB_XCNT(j)  (256  + 64 * (j))
#define XB_XSUB(j)  (1280 + 64 * (j))
#define XB_XGEN(j)  (2304 + 64 * (j))
#define XB_TOP      3328
#define XB_TOPGEN   3392
#define XCD_BAR_WORDS 3456
#define XB_SPIN_CAP (1u << 20)
__device__ __forceinline__ unsigned xb_ld(unsigned* p)              { return __hip_atomic_load(p, __ATOMIC_RELAXED, __HIP_MEMORY_SCOPE_AGENT); }
__device__ __forceinline__ unsigned xb_add(unsigned* p, unsigned v) { return __hip_atomic_fetch_add(p, v, __ATOMIC_RELAXED, __HIP_MEMORY_SCOPE_AGENT); }
__device__ __forceinline__ unsigned xb_xcc_id() { return (unsigned)__builtin_amdgcn_s_getreg((3 << 11) | 20) & 0xFu; }
#define XB_SPIN(cond, bar) do { unsigned _sp = 0; while (cond) { __builtin_amdgcn_s_sleep(1); \
    if ((++_sp & 255u) == 0u) { if (xb_ld(&(bar)[XB_TMO])) break; if (_sp > XB_SPIN_CAP) { atomicAdd(&(bar)[XB_TMO], 1u); break; } } } } while (0)
__device__ __forceinline__ void xcd_barrier_complete(unsigned* bar, unsigned x, unsigned G, unsigned& nloc, unsigned& nx) {
    unsigned sum, cnt, mine, sp = 0u;
    for (;;) {
        sum = 0u; cnt = 0u; mine = 0u;
#pragma unroll
        for (unsigned j = 0; j < 16; ++j) { const unsigned c = xb_ld(&bar[XB_XCNT(j)]); sum += c; cnt += (c > 0u) ? 1u : 0u; mine = (j == x) ? c : mine; }
        if (sum == G) break;
        __builtin_amdgcn_s_sleep(1);
        if ((++sp & 255u) == 0u) { if (xb_ld(&bar[XB_TMO])) break; if (sp > XB_SPIN_CAP) { atomicAdd(&bar[XB_TMO], 1u); break; } }
    }
    nloc = mine > 0u ? mine : 1u; nx = cnt > 0u ? cnt : 1u;
}
__device__ __forceinline__ void xcd_barrier(unsigned* bar, unsigned x, volatile LAS unsigned* st, unsigned G, int wave) {
    asm volatile("s_waitcnt vmcnt(0)" ::: "memory");
    __syncthreads();
    if (wave == 0) { if (lane_id() == 0) {
        __builtin_amdgcn_s_waitcnt(0);
        unsigned nloc = st[0], nx = st[1];
        if (nloc == 0u) { xcd_barrier_complete(bar, x, G, nloc, nx); st[0] = nloc; st[1] = nx; }
        const unsigned old = xb_add(&bar[XB_XSUB(x)], 1u);
        const unsigned gen = old / nloc;
        if (old + 1u == (gen + 1u) * nloc) {
            __builtin_amdgcn_fence(__ATOMIC_RELEASE, "agent");
            asm volatile("s_waitcnt vmcnt(0)" ::: "memory");
            const unsigned og = xb_add(&bar[XB_TOP], 1u);
            const unsigned tg = og / nx;
            if (og + 1u == (tg + 1u) * nx) xb_add(&bar[XB_TOPGEN], 1u);
            else XB_SPIN(xb_ld(&bar[XB_TOP]) / nx == tg, bar);
            xb_add(&bar[XB_XGEN(x)], 1u);
            __builtin_amdgcn_fence(__ATOMIC_ACQUIRE, "agent");
            asm volatile("s_waitcnt vmcnt(0)" ::: "memory");
        } else {
            XB_SPIN(xb_ld(&bar[XB_XGEN(x)]) == gen, bar);
            __builtin_amdgcn_fence(__ATOMIC_ACQUIRE, "agent");
            asm volatile("s_waitcnt vmcnt(0)" ::: "memory");
        }
    } }
    __syncthreads();
}

constexpr int N_PHASES = 16;
constexpr int LDS_BYTES = 147456;
enum PhaseKind { PK_PRO = 0, PK_ABIN, PK_ABATT, PK_OUT, PK_CIN, PK_CQKV, PK_CATT, PK_FIN };
__host__ __device__ constexpr int phase_kind(int p) {
    return p == 0 ? PK_PRO : p == 15 ? PK_FIN : (p == 1 || p == 8) ? PK_ABIN : (p == 2 || p == 9) ? PK_ABATT : (p == 3 || p == 10 || p == 7 || p == 14) ? PK_OUT
         : (p == 4 || p == 11) ? PK_CIN : (p == 5 || p == 12) ? PK_CQKV : PK_CATT;
}
__host__ __device__ constexpr int phase_layer(int p) { return p <= 3 ? 0 : p <= 7 ? 1 : p <= 10 ? 2 : 3; }

__host__ __device__ inline Gemm make_gemm(const Args& a, int p, int which) {
    unsigned char* ws = a.ws; const int kind = phase_kind(p), layer = phase_layer(p), li = layer >> 1;
    const bf16_t* XB = (const bf16_t*)(ws + WS_XB); const bf16_t* Gb = (const bf16_t*)(ws + WS_G);
    if (kind == PK_ABIN) return Gemm{XB, (const bf16_t*)(ws + W_ABIN) + (size_t)li * AB_IN * DM, T, AB_IN, DM, 0};
    if (kind == PK_OUT) return Gemm{Gb, (const bf16_t*)(ws + ((layer & 1) ? W_COUT : W_ABOUT)) + (size_t)li * DM * DM, T, DM, DM, 0};
    if (kind == PK_CIN) return Gemm{XB, (const bf16_t*)(ws + W_CIN) + (size_t)li * C_INP * DM, T, C_INP, DM, 0};
    if (which == 0) return Gemm{(const bf16_t*)(ws + WS_CQ), (const bf16_t*)(ws + W_CQB) + (size_t)li * 1536 * 256, T, 1536, 256, 0};
    return Gemm{(const bf16_t*)(ws + WS_CKV), (const bf16_t*)(ws + W_CKVB) + (size_t)li * 2048 * 128, T, 2048, 128, 0};
}
__host__ __device__ inline EpiABin make_epi_abin(const Args& a) { return EpiABin{(bf16_t*)(a.ws + WS_QKV), (bf16_t*)(a.ws + WS_G), (const float*)(a.ws + WS_SSQ)}; }
__host__ __device__ inline EpiOut make_epi_out(const Args& a, int p) { (void)p; return EpiOut{(bf16_t*)(a.ws + WS_XB), (unsigned char*)a.out, (float*)(a.ws + WS_SSQ)}; }
__host__ __device__ inline EpiCin make_epi_cin(const Args& a) {
    return EpiCin{(bf16_t*)(a.ws + WS_CQ), (bf16_t*)(a.ws + WS_CKV), (bf16_t*)(a.ws + WS_KPE), (bf16_t*)(a.ws + WS_G), (const float*)(a.ws + WS_SSQ),
                  (float*)(a.ws + WS_SSQQ), (float*)(a.ws + WS_SSQKV), (const float*)(a.ws + WS_ROPE), 0, 0}; }
__host__ __device__ inline EpiQ make_epi_q(const Args& a) { return EpiQ{(bf16_t*)(a.ws + WS_Q), (const float*)(a.ws + WS_SSQQ), (const float*)(a.ws + WS_ROPE)}; }
__host__ __device__ inline EpiKV make_epi_kv(const Args& a) { return EpiKV{(bf16_t*)(a.ws + WS_K), (bf16_t*)(a.ws + WS_V), (const float*)(a.ws + WS_SSQKV)}; }

__global__ void __launch_bounds__(512, 2) fwd(Args a) {
    extern __shared__ __attribute__((aligned(16))) unsigned char lds_raw[];
    LAS unsigned char* lds = (LAS unsigned char*)lds_raw;
    const int G = gridDim.x, bx = blockIdx.x;
    const int vcu = (G % 8 == 0) ? (bx % 8) * (G / 8) + bx / 8 : bx;
    const int wave = __builtin_amdgcn_readfirstlane(threadIdx.x >> 6);
    volatile LAS unsigned* bst = (volatile LAS unsigned*)(lds + LDS_BYTES - 64);
    unsigned* barw = (unsigned*)(a.ws + WS_CTL) + 1024;
    const unsigned xcc = xb_xcc_id();
    if (wave == 0) { if (lane_id() == 0) { bst[0] = 0u; bst[1] = 0u; (void)xb_add(&barw[XB_XCNT(xcc)], 1u); } }
    __syncthreads();
#if defined(PROBE_KIND) && PROBE_KIND == 7
#define GRID_SYNC() do { for (int rb_ = 0; rb_ < 1 + PROBE_N; ++rb_) xcd_barrier(barw, xcc, bst, (unsigned)G, wave); } while (0)
#else
#define GRID_SYNC() xcd_barrier(barw, xcc, bst, (unsigned)G, wave)
#endif
    int p0 = a.ph_lo;
    if (p0 == 0 && a.ph_hi > 0) {
        int lane = lane_id(); asm volatile("" : "+v"(lane));
        for (int rep_ = 0; rep_ < PROBE_REPS(PK_PRO, true); ++rep_) { prologue<0>(a, lds, vcu * 8 + wave, G * 8, lane, wave); __syncthreads(); }
        if (a.ph_hi == 1) { prologue<3>(a, lds, vcu * 8 + wave, G * 8, lane, wave); __syncthreads(); }
        p0 = 1;
    }
    const int p1 = a.ph_hi < 15 ? a.ph_hi : 15;
    const bool fuse_fin = (a.ph_hi == 16 && G == (T / BM) * (DM / BM));
    for (int p = p0; p < p1; ++p) {
        if (p > a.ph_lo) GRID_SYNC();
#define WS_HERE(w) __attribute__((address_space(1))) unsigned char* w##_g = (__attribute__((address_space(1))) unsigned char*)a.ws; asm volatile("" : "+s"(w##_g)); unsigned char* w = (unsigned char*)w##_g
        const int kind = phase_kind(p), layer = phase_layer(p), li = layer >> 1;
        if (kind == PK_CQKV) {
#if FAST_GEMM
            for (int rep_ = 0; rep_ < PROBE_REPS(PK_CQKV, true); ++rep_) {
            if (G == 256) {
                int vcu_o = vcu; asm volatile("" : "+s"(vcu_o));
#define vcu vcu_o
                const int ox_ = vcu >> 5, oj_ = vcu & 31, ojj_ = oj_ - 16, opm_ = ox_ * 8 + ((oj_ & 15) >> 1);
                const bool otA_ = oj_ < 16;
                { WS_HERE(ws); const Gemm g{(const bf16_t*)(ws + WS_XB), (const bf16_t*)(ws + W_CIN) + (size_t)li * C_INP * DM + (size_t)1024 * DM, T, 512, DM, 0};
                  const ListOrder so{opm_ * 2 + (oj_ & 1), otA_ ? 1 : 0, 2};
                  gemm_phase<EpiCin, ListOrder, true, true>(lds, g, so, EpiCin{(bf16_t*)(ws + WS_CQ), (bf16_t*)(ws + WS_CKV), (bf16_t*)(ws + WS_KPE), (bf16_t*)(ws + WS_G), (const float*)(ws + WS_SSQ),
                      (float*)(ws + WS_SSQQ), (float*)(ws + WS_SSQKV), (const float*)(ws + WS_ROPE), 4, 0}, wave); }
                { WS_HERE(ws); const Gemm g{(const bf16_t*)(ws + WS_CQ), (const bf16_t*)(ws + W_CQB) + (size_t)li * 1536 * 256, T, 1536, 256, 0};
                  const ListOrder so{otA_ ? opm_ * 6 + (oj_ & 1) : opm_ * 6 + 2 + 2 * (ojj_ & 1), otA_ ? 1 : 2, 6};
                  gemm_phase<EpiQ, ListOrder, true, true>(lds, g, so, EpiQ{(bf16_t*)(ws + WS_Q), (const float*)(ws + WS_SSQQ), (const float*)(ws + WS_ROPE)}, wave); }
                { WS_HERE(ws); const Gemm g{(const bf16_t*)(ws + WS_CKV), (const bf16_t*)(ws + W_CKVB) + (size_t)li * 2048 * 128, T, 2048, 128, 0};
                  const ListOrder so{otA_ ? 0 : opm_ * 8 + 4 * (ojj_ & 1), otA_ ? 0 : 4, 8};
                  gemm_phase<EpiKV, ListOrder, true, true>(lds, g, so, EpiKV{(bf16_t*)(ws + WS_K), (bf16_t*)(ws + WS_V), (const float*)(ws + WS_SSQKV)}, wave); }
#undef vcu
            } else {
            { WS_HERE(ws); const Gemm g{(const bf16_t*)(ws + WS_CQ), (const bf16_t*)(ws + W_CQB) + (size_t)li * 1536 * 256, T, 1536, 256, 0}; StaticOrder so; so.init(T, 1536, G, bx);
              gemm_phase<EpiQ, StaticOrder, true, true>(lds, g, so, EpiQ{(bf16_t*)(ws + WS_Q), (const float*)(ws + WS_SSQQ), (const float*)(ws + WS_ROPE)}, wave); }
            { WS_HERE(ws); const Gemm g{(const bf16_t*)(ws + WS_CKV), (const bf16_t*)(ws + W_CKVB) + (size_t)li * 2048 * 128, T, 2048, 128, 0}; StaticOrder so; so.init(T, 2048, G, bx);
              gemm_phase<EpiKV, StaticOrder, true, true>(lds, g, so, EpiKV{(bf16_t*)(ws + WS_K), (bf16_t*)(ws + WS_V), (const float*)(ws + WS_SSQKV)}, wave); }
            }
            }
#endif
        }
#if FAST_GEMM
        else if (kind == PK_ABIN) for (int rep_ = 0; rep_ < PROBE_REPS(PK_ABIN, true); ++rep_) { WS_HERE(ws);
            const bool split_tail = (p == 8 && G == 256);
            const int ncol = split_tail ? 12 * BM : AB_IN;
            const Gemm g{(const bf16_t*)(ws + WS_XB), (const bf16_t*)(ws + W_ABIN) + (size_t)li * AB_IN * DM, T, ncol, DM, 0}; StaticOrder so; so.init(T, ncol, G, bx);
            gemm_phase<EpiABin, StaticOrder, true, true>(lds, g, so, EpiABin{(bf16_t*)(ws + WS_QKV), (bf16_t*)(ws + WS_G), (const float*)(ws + WS_SSQ)}, wave);
            if (split_tail) { if ((vcu & 31) < 16) { WS_HERE(ws2);
                const int hpm = (vcu >> 5) * 8 + ((vcu & 31) >> 1), half = vcu & 1;
                const Gemm g2{(const bf16_t*)(ws2 + WS_XB), (const bf16_t*)(ws2 + W_ABIN) + (size_t)li * AB_IN * DM + (size_t)(12 * BM + half * 128) * DM, T, BM, DM, 0};
                const ListOrder so2{hpm, 1, 1};
                gemm_phase<EpiABinHalf, ListOrder, true, true, true>(lds, g2, so2, EpiABinHalf{(bf16_t*)(ws2 + WS_G), (const float*)(ws2 + WS_SSQ), half * 128, 0}, wave); } }
            if (rep_ == 0 && a.ph_lo == 0 && (p == 1 || (p == 8 && a.ph_hi > 8))) {
                const int nfull = (T / BM) * (AB_IN / BM) / G, rem = (T / BM) * (AB_IN / BM) - nfull * G;
                const bool some_idle = (rem > 0 && rem < G);
                if (!some_idle || bx >= rem) {
                    int lane = lane_id(); asm volatile("" : "+v"(lane));
                    const int cgw = some_idle ? (bx - rem) * 8 + wave : vcu * 8 + wave, cn = some_idle ? (G - rem) * 8 : G * 8;
                    if (p == 1) prologue<3>(a, lds, cgw, cn, lane, wave);
                }
                __syncthreads();
            } }
        else if (kind == PK_OUT && p == 14 && fuse_fin) { WS_HERE(ws); const Gemm g{(const bf16_t*)(ws + WS_G), (const bf16_t*)(ws + W_COUT) + (size_t)li * DM * DM, T, DM, DM, 0}; StaticOrder so; so.init(T, DM, G, bx);
            gemm_phase<EpiOutFin, StaticOrder, true, true>(lds, g, so, EpiOutFin{(const bf16_t*)(ws + WS_XB), (const unsigned char*)a.out, a.out, (float*)(ws + WS_SSQ), (unsigned*)(ws + WS_FCNT), a.final_norm}, wave); }
        else if (kind == PK_OUT) for (int rep_ = 0; rep_ < PROBE_REPS(PK_OUT, layer == 0); ++rep_) { WS_HERE(ws); const Gemm g{(const bf16_t*)(ws + WS_G), (const bf16_t*)(ws + ((layer & 1) ? W_COUT : W_ABOUT)) + (size_t)li * DM * DM, T, DM, DM, 0}; StaticOrder so; so.init(T, DM, G, bx);
            gemm_phase<EpiOut, StaticOrder, true, true>(lds, g, so, EpiOut{(bf16_t*)(ws + WS_XB), (unsigned char*)a.out, (float*)(ws + WS_SSQ)}, wave); }
        else if (kind == PK_CIN) for (int rep_ = 0; rep_ < PROBE_REPS(PK_CIN, true); ++rep_) { WS_HERE(ws);
            const int ncin = (G == 256) ? 1024 : C_INP;
            const Gemm g{(const bf16_t*)(ws + WS_XB), (const bf16_t*)(ws + W_CIN) + (size_t)li * C_INP * DM, T, ncin, DM, 0}; StaticOrder so; so.init(T, ncin, G, bx);
            gemm_phase<EpiCin, StaticOrder, true, true>(lds, g, so, EpiCin{(bf16_t*)(ws + WS_CQ), (bf16_t*)(ws + WS_CKV), (bf16_t*)(ws + WS_KPE), (bf16_t*)(ws + WS_G), (const float*)(ws + WS_SSQ),
                  (float*)(ws + WS_SSQQ), (float*)(ws + WS_SSQKV), (const float*)(ws + WS_ROPE), 0, 0}, wave); }
#endif
#if FAST_MLA
        else if (kind == PK_CATT) { WS_HERE(ws);
            PROBE_DRY_REPS(PK_CATT, (mla2::phase<true>((char*)lds_raw, (const bf16_t*)(ws + WS_Q), (const bf16_t*)(ws + WS_K), (const bf16_t*)(ws + WS_KPE), (const bf16_t*)(ws + WS_V), (bf16_t*)(ws + WS_G), vcu, G, wave)));
            mla2::phase<false>((char*)lds_raw, (const bf16_t*)(ws + WS_Q), (const bf16_t*)(ws + WS_K), (const bf16_t*)(ws + WS_KPE), (const bf16_t*)(ws + WS_V), (bf16_t*)(ws + WS_G), vcu, G, wave); }
#endif
#if FAST_BAND
        else if (kind == PK_ABATT) { WS_HERE(ws); int lane = lane_id(); asm volatile("" : "+v"(lane));
            PROBE_DRY_REPS(PK_ABATT, (band::phase<true>(lds, (const bf16_t*)(ws + WS_QKV), (bf16_t*)(ws + WS_G), (bf16_t*)(ws + WS_OC), (float*)(ws + WS_LSE), (const float*)(ws + WS_BT), a.ab_sinks + li * 8, vcu, G, wave, lane)));
            band::phase<false>(lds, (const bf16_t*)(ws + WS_QKV), (bf16_t*)(ws + WS_G), (bf16_t*)(ws + WS_OC), (float*)(ws + WS_LSE), (const float*)(ws + WS_BT), a.ab_sinks + li * 8, vcu, G, wave, lane); }
#endif
    }
    if (a.ph_hi == 16 && !(fuse_fin && a.ph_lo <= 14)) {
        if (15 > a.ph_lo) GRID_SYNC();
        int lane = lane_id(); asm volatile("" : "+v"(lane));
        final_norm_phase(a, vcu * 8 + wave, G * 8, lane);
    }
}

extern "C" void kernel_launch(void* const* d_in, const int* in_sizes, int n_in, void* d_out, int out_size, void* d_ws, size_t ws_size, hipStream_t stream) {
    static int grid = 0;
    if (grid == 0) {
        if (n_in != 14 || in_sizes[0] != T * DM || out_size != T * DM || ws_size < WS_END) {
            fprintf(stderr, "kernel_launch: unexpected shapes: n_in %d in0 %d out %d ws %zu (need >= %zu)\n", n_in, n_in > 0 ? in_sizes[0] : -1, out_size, ws_size, (size_t)WS_END);
            grid = -1; return; }
        int dev = 0, cus = 0, per_cu = 0;
        hipGetDevice(&dev); hipDeviceGetAttribute(&cus, hipDeviceAttributeMultiprocessorCount, dev);
        if (hipFuncSetAttribute((const void*)fwd, hipFuncAttributeMaxDynamicSharedMemorySize, LDS_BYTES) != hipSuccess) { fprintf(stderr, "kernel_launch: hipFuncSetAttribute failed\n"); grid = -1; return; }
        hipOccupancyMaxActiveBlocksPerMultiprocessor(&per_cu, (const void*)fwd, 512, LDS_BYTES);
        if (per_cu < 1) { fprintf(stderr, "kernel_launch: occupancy query says %d blocks per CU\n", per_cu); per_cu = 1; }
        (void)hipGetLastError();
        grid = cus;
        if (grid * 8 < (T / BM) * (AB_IN / BM)) { fprintf(stderr, "kernel_launch: %d CUs: more than 8 GEMM units per workgroup (row-scale table)\n", cus); grid = -1; return; }
    }
    if (grid < 0) return;
    Args a{};
    a.x = (const float*)d_in[0]; a.pos = (const int*)d_in[1]; a.norm_w = (const float*)d_in[2]; a.rel_bias = (const float*)d_in[3];
    a.ab_w_in = (const float*)d_in[4]; a.ab_sinks = (const float*)d_in[5]; a.ab_w_out = (const float*)d_in[6]; a.c_w_in = (const float*)d_in[7];
    a.c_q_norm = (const float*)d_in[8]; a.c_w_qb = (const float*)d_in[9]; a.c_kv_norm = (const float*)d_in[10]; a.c_w_kvb = (const float*)d_in[11];
    a.c_w_out = (const float*)d_in[12]; a.final_norm = (const float*)d_in[13];
    a.out = (float*)d_out; a.ws = (unsigned char*)d_ws;
    unsigned char* ws = (unsigned char*)d_ws;
    int lo = -1;
    auto flush = [&](int hi) {
        if (lo >= 0 && hi > lo) {
            a.ph_lo = lo; a.ph_hi = hi;
            (void)hipMemsetAsync((unsigned char*)d_ws + WS_CTL, 0, 65536, stream);
            hipLaunchKernelGGL(fwd, dim3(grid), dim3(512), LDS_BYTES, stream, a);
            hipError_t e = hipPeekAtLastError();
            if (e != hipSuccess) fprintf(stderr, "kernel_launch: launch of phases [%d,%d) failed: %s\n", lo, hi, hipGetErrorString(e));
        }
        lo = -1;
    };
    for (int p = 0; p < N_PHASES; ++p) {
        const int kind = phase_kind(p), li = phase_layer(p) >> 1;
        bool in_fwd = true;
        const bool gemm_kind = (kind == PK_ABIN || kind == PK_OUT || kind == PK_CIN || kind == PK_CQKV);
        if (!FAST_GEMM && gemm_kind) {
            flush(p);
            if (kind == PK_ABIN) hipLaunchKernelGGL(naive_gemm_k<EpiABin>, dim3(2048), dim3(256), 0, stream, make_gemm(a, p, 0), make_epi_abin(a));
            else if (kind == PK_OUT) hipLaunchKernelGGL(naive_gemm_k<EpiOut>, dim3(2048), dim3(256), 0, stream, make_gemm(a, p, 0), make_epi_out(a, p));
            else if (kind == PK_CIN) hipLaunchKernelGGL(naive_gemm_k<EpiCin>, dim3(2048), dim3(256), 0, stream, make_gemm(a, p, 0), make_epi_cin(a));
            else { hipLaunchKernelGGL(naive_gemm_k<EpiQ>, dim3(2048), dim3(256), 0, stream, make_gemm(a, p, 0), make_epi_q(a));
                   hipLaunchKernelGGL(naive_gemm_k<EpiKV>, dim3(2048), dim3(256), 0, stream, make_gemm(a, p, 1), make_epi_kv(a)); }
            in_fwd = (kind == PK_CQKV);
        } else if (kind == PK_ABATT && !FAST_BAND) {
            flush(p);
            hipLaunchKernelGGL(naive_ab_attn, dim3(1024), dim3(256), 0, stream, (const bf16_t*)(ws + WS_QKV), (bf16_t*)(ws + WS_G), (const float*)(ws + WS_BT), a.ab_sinks + li * 8);
            in_fwd = false;
        } else if (kind == PK_CATT && !FAST_MLA) {
            flush(p);
            hipLaunchKernelGGL(naive_mla_attn, dim3(1024), dim3(256), 0, stream, (const bf16_t*)(ws + WS_Q), (const bf16_t*)(ws + WS_K), (const bf16_t*)(ws + WS_KPE), (const bf16_t*)(ws + WS_V), (bf16_t*)(ws + WS_G));
            in_fwd = false;
        }
        if (in_fwd && lo < 0) lo = p;
        if (!in_fwd) lo = -1;
    }
    flush(N_PHASES);
}
```

```cpp
#include <hip/hip_runtime.h>
#include <cstdio>
#include <cstdint>

#ifndef FAST_GEMM
#define FAST_GEMM 1
#endif
#ifndef FAST_MLA
#define FAST_MLA 1
#endif
#ifndef MLA_V2
#define MLA_V2 1
#endif
#ifndef FAST_BAND
#define FAST_BAND 1
#endif

#if defined(PROBE_KIND)
#define PROBE_DRY_REPS(K_, CALL) do { if ((K_) == PROBE_KIND) { for (int rep_ = 0; rep_ < PROBE_N; ++rep_) { CALL; __syncthreads(); } } } while (0)
#define PROBE_REPS(K_, COND) (((K_) == PROBE_KIND && (COND)) ? 1 + PROBE_N : 1)
#else
#define PROBE_DRY_REPS(K_, CALL) do { } while (0)
#define PROBE_REPS(K_, COND) 1
#endif

constexpr int NB = 4, S = 4096, T = NB * S, DM = 1024;
constexpr int AB_IN = 3328, QKV_W = 2304;
constexpr int C_IN = 1440, C_INP = 1536;
constexpr float EPS = 1e-6f;
constexpr float LOG2E = 1.4426950408889634f;
constexpr float CQ_AB = 0.125f * LOG2E;
constexpr float CQ_C = 0.10206207261596577f * LOG2E;

constexpr size_t MiB = 1u << 20;
constexpr size_t WS_CTL = 0;
constexpr size_t WS_OXCC = 61440;
constexpr size_t WS_OBAR = 62464;
constexpr size_t WS_PBAR = 65536;
constexpr size_t WS_FCNT = 32768;
constexpr size_t WS_SSQ = 1 * MiB;
constexpr size_t WS_SSQQ = 2 * MiB;
constexpr size_t WS_SSQKV = 2 * MiB + 256 * 1024;
constexpr size_t WS_ROPE = 3 * MiB;
constexpr size_t WS_BT = 5 * MiB;
constexpr size_t WS_W = 6 * MiB;
constexpr size_t W_ABIN = WS_W;
constexpr size_t W_ABOUT = W_ABIN + 2 * (size_t)AB_IN * DM * 2;
constexpr size_t W_CIN = W_ABOUT + 2 * (size_t)DM * DM * 2;
constexpr size_t W_CQB = W_CIN + 2 * (size_t)C_INP * DM * 2;
constexpr size_t W_CKVB = W_CQB + 2 * (size_t)1536 * 256 * 2;
constexpr size_t W_COUT = W_CKVB + 2 * (size_t)2048 * 128 * 2;
constexpr size_t W_END = W_COUT + 2 * (size_t)DM * DM * 2;
static_assert(W_END <= 38 * MiB, "weights");
constexpr size_t WS_XB = 38 * MiB;
constexpr size_t WS_G = 70 * MiB;
constexpr size_t WS_R = 102 * MiB;
constexpr size_t RGN = 32 * MiB;
constexpr size_t WS_QKV = WS_R;
constexpr size_t WS_OC = WS_R + 18 * MiB;
constexpr size_t WS_LSE = WS_R + 30 * MiB;
constexpr size_t WS_CQ = WS_R;
constexpr size_t WS_CKV = WS_R + 2 * MiB;
constexpr size_t WS_KPE = WS_R + 3 * MiB;
constexpr size_t WS_Q = WS_R + 4 * MiB;
constexpr size_t WS_K = WS_R + 16 * MiB;
constexpr size_t WS_V = WS_R + 24 * MiB;
constexpr size_t WS_END = WS_R + 4 * RGN;
constexpr long D_QKV = (long)(RGN / 2) - 4096L * 2304, D_CQ = (long)(RGN / 2) - 4096L * 256, D_CKV = (long)(RGN / 2) - 4096L * 128, D_KPE = (long)(RGN / 2) - 4096L * 32,
               D_Q = (long)(RGN / 2) - 4096L * 1536, D_KV = (long)(RGN / 2) - 4096L * 1024, D_OC = (long)(RGN / 2) - 4096L * 512, D_LSE = (long)(RGN / 4) - 4096L * 8;
static_assert(WS_END <= 256 * MiB, "workspace");

typedef unsigned short bf16_t;
typedef short bf16x8 __attribute__((ext_vector_type(8)));
typedef float f32x4 __attribute__((ext_vector_type(4)));
typedef float f32x2 __attribute__((ext_vector_type(2)));
typedef unsigned u32x4 __attribute__((ext_vector_type(4)));
typedef unsigned u32x2 __attribute__((ext_vector_type(2)));
typedef __bf16 bf16x2_t __attribute__((ext_vector_type(2)));
#define LAS __attribute__((address_space(3)))

__device__ __forceinline__ unsigned pk2(float lo, float hi) { f32x2 v = {lo, hi}; bf16x2_t b = __builtin_convertvector(v, bf16x2_t); return __builtin_bit_cast(unsigned, b); }
__device__ __forceinline__ float bflo(unsigned w) { return __uint_as_float(w << 16); }
__device__ __forceinline__ float bfhi(unsigned w) { return __uint_as_float(w & 0xffff0000u); }
__device__ __forceinline__ float bf2f(bf16_t h) { return __uint_as_float((unsigned)h << 16); }
__device__ __forceinline__ float silu_f(float v) { return v * __builtin_amdgcn_rcpf(1.f + __builtin_amdgcn_exp2f(v * -LOG2E)); }
__device__ __forceinline__ float dot8(bf16x8 a, bf16x8 b, float acc) {
    const u32x4 ua = __builtin_bit_cast(u32x4, a), ub = __builtin_bit_cast(u32x4, b);
#pragma unroll
    for (int i = 0; i < 4; ++i) { acc = fmaf(bflo(ua[i]), bflo(ub[i]), acc); acc = fmaf(bfhi(ua[i]), bfhi(ub[i]), acc); }
    return acc;
}
__device__ __forceinline__ int lane_id() { unsigned z = 0u; asm volatile("" : "+v"(z)); return (int)__builtin_amdgcn_mbcnt_hi(~0u, __builtin_amdgcn_mbcnt_lo(~0u, z)); }
__device__ __forceinline__ float wave_sum(float v) {
#pragma unroll
    for (int o = 1; o < 64; o <<= 1) v += __shfl_xor(v, o);
    return v;
}

constexpr int BM = 256, NXCD = 8, WGM = 8;
struct Unit { int pm, pn; };
struct Gemm { const bf16_t* A; const bf16_t* Bt; int M, N, K, pad; };
struct StaticOrder {
    int nM, nN, nwg, G, c;
    __device__ void init(int M, int N, int G_, int c_) { nM = M / BM; nN = N / BM; nwg = nM * nN; G = G_; c = c_; }
    __device__ bool next(int i, Unit& u) const {
        const long L = (long)i * G + c; if (L >= nwg) return false;
        int wgid = (int)L; { const int q = nwg / NXCD, r = nwg % NXCD, xcd = wgid % NXCD, off = wgid / NXCD; wgid = (xcd < r ? xcd * (q + 1) : r * (q + 1) + (xcd - r) * q) + off; }
        const int nig = WGM * nN, gid = wgid / nig, fm = gid * WGM, gsz = (nM - fm) < WGM ? (nM - fm) : WGM;
        u.pm = fm + ((wgid % nig) % gsz); u.pn = (wgid % nig) / gsz; return true;
    }
    __device__ __forceinline__ void a_ready(const Unit&) const {}
    __device__ __forceinline__ void done(const Unit&) const {}
};

struct ListOrder {
    int first, cnt, nN, stride = 1;
    __device__ bool next(int i, Unit& u) const { if (i >= cnt) return false; const int L = first + i * stride; u.pm = L / nN; u.pn = L - u.pm * nN; return true; }
    __device__ __forceinline__ void a_ready(const Unit&) const {}
    __device__ __forceinline__ void done(const Unit&) const {}
};

__device__ __forceinline__ float rowscale16(const float* ssq, int row) {
    const f32x4* p = (const f32x4*)(ssq + (size_t)row * 16);
    const f32x4 a = p[0], b = p[1], c = p[2], d = p[3];
    const float s = ((a.x + a.y) + (a.z + a.w)) + ((b.x + b.y) + (b.z + b.w)) + ((c.x + c.y) + (c.z + c.w)) + ((d.x + d.y) + (d.z + d.w));
    return rsqrtf(s * (1.f / 1024.f) + EPS);
}
__device__ __forceinline__ float rowscale4(const float* ssq, int row, float inv_n) {
    const f32x4 a = *(const f32x4*)(ssq + (size_t)row * 4);
    return rsqrtf(((a.x + a.y) + (a.z + a.w)) * inv_n + EPS);
}

__device__ __forceinline__ void load_rowscales16(const float* ssq, int row0  , int fq, float mul, float (&rs)[2][4]) {
    f32x4 v[2][4];
#pragma unroll
    for (int ai = 0; ai < 2; ++ai)
#pragma unroll
        for (int m = 0; m < 4; ++m) v[ai][m] = *(const f32x4*)(ssq + (size_t)(row0 + ai * 128 + m * 16) * 16 + 4 * fq);
#pragma unroll
    for (int ai = 0; ai < 2; ++ai)
#pragma unroll
        for (int m = 0; m < 4; ++m) {
            float t = (v[ai][m][0] + v[ai][m][1]) + (v[ai][m][2] + v[ai][m][3]);
            t += __shfl_xor(t, 16); t += __shfl_xor(t, 32);
            rs[ai][m] = rsqrtf(t * (1.f / 1024.f) + EPS) * mul;
        }
}
__device__ __forceinline__ void load_rowscales4(const float* ssq, int row0, float inv_n, float mul, float (&rs)[2][4]) {
    f32x4 v[2][4];
#pragma unroll
    for (int ai = 0; ai < 2; ++ai)
#pragma unroll
        for (int m = 0; m < 4; ++m) v[ai][m] = *(const f32x4*)(ssq + (size_t)(row0 + ai * 128 + m * 16) * 4);
#pragma unroll
    for (int ai = 0; ai < 2; ++ai)
#pragma unroll
        for (int m = 0; m < 4; ++m) rs[ai][m] = rsqrtf(((v[ai][m][0] + v[ai][m][1]) + (v[ai][m][2] + v[ai][m][3])) * inv_n + EPS) * mul;
}

__device__ __forceinline__ void lds_rowscales(const LAS float* rst, int wr, int fr, float mul, float (&rs)[2][4]) {
#pragma unroll
    for (int ai = 0; ai < 2; ++ai)
#pragma unroll
        for (int m = 0; m < 4; ++m) rs[ai][m] = rst[wr * 64 + fr + ai * 128 + m * 16] * mul;
}
struct EpiABin {
    static constexpr bool PERM = true, AFTER_DRAIN = false;
    bf16_t* QKV0; bf16_t* G; const float* ssq;
    static constexpr int RS_KIND = 16; __device__ __forceinline__ const float* rs_ptr() const { return ssq; } __device__ __forceinline__ float rs_inv() const { return 1.f / 1024.f; }
    template <bool LRS = false>
    __device__ __forceinline__ void operator()(const f32x4 (&acc)[2][2][4][2], const Unit& u, int wr, int wc, int fr, int fq, const LAS float* rst = nullptr) const {
        bf16_t* QKV = QKV0 + (long)(u.pm >> 4) * D_QKV;
        const int pn = u.pn;
        const int mode = (pn >= 9) ? 2 : ((pn < 2 || pn == 3 || pn == 4) ? 1 : 0);
        const int row0 = u.pm * BM + wr * 64 + fr;
        float rs[2][4]; if (LRS) lds_rowscales(rst, wr, fr, mode == 1 ? CQ_AB : 1.f, rs); else load_rowscales16(ssq, row0, fq, mode == 1 ? CQ_AB : 1.f, rs);
#pragma unroll
        for (int ai = 0; ai < 2; ++ai)
#pragma unroll
            for (int m = 0; m < 4; ++m) {
                const int row = row0 + ai * 128 + m * 16;
#pragma unroll
                for (int bj = 0; bj < 2; ++bj) {
                    f32x4 v0 = acc[ai][bj][m][0] * rs[ai][m], v1 = acc[ai][bj][m][1] * rs[ai][m];
                    if (mode == 2) {
#pragma unroll
                        for (int e = 0; e < 4; ++e) { v0[e] = silu_f(v0[e]); v1[e] = silu_f(v1[e]); }
                    }
                    const int col = pn * BM + bj * 128 + wc * 32 + 8 * fq;
                    u32x4 w; w.x = pk2(v0[0], v0[1]); w.y = pk2(v0[2], v0[3]); w.z = pk2(v1[0], v1[1]); w.w = pk2(v1[2], v1[3]);
                    if (mode == 2) *(u32x4*)(G + (size_t)row * DM + (col - QKV_W)) = w;
                    else *(u32x4*)(QKV + (size_t)row * QKV_W + col) = w;
                }
            }
    }
};
struct EpiABinHalf {
    static constexpr bool PERM = true, AFTER_DRAIN = false;
    bf16_t* G; const float* ssq; int colofs, pad;
    static constexpr int RS_KIND = 16; __device__ __forceinline__ const float* rs_ptr() const { return ssq; } __device__ __forceinline__ float rs_inv() const { return 1.f / 1024.f; }
    template <bool LRS = false>
    __device__ __forceinline__ void operator()(const f32x4 (&acc)[2][2][4][2], const Unit& u, int wr, int wc, int fr, int fq, const LAS float* rst = nullptr) const {
        const int row0 = u.pm * BM + wr * 64 + fr;
        float rs[2][4]; if (LRS) lds_rowscales(rst, wr, fr, 1.f, rs); else load_rowscales16(ssq, row0, fq, 1.f, rs);
#pragma unroll
        for (int ai = 0; ai < 2; ++ai)
#pragma unroll
            for (int m = 0; m < 4; ++m) {
                const int row = row0 + ai * 128 + m * 16;
                f32x4 v0 = acc[ai][0][m][0] * rs[ai][m], v1 = acc[ai][0][m][1] * rs[ai][m];
#pragma unroll
                for (int e = 0; e < 4; ++e) { v0[e] = silu_f(v0[e]); v1[e] = silu_f(v1[e]); }
                u32x4 w; w.x = pk2(v0[0], v0[1]); w.y = pk2(v0[2], v0[3]); w.z = pk2(v1[0], v1[1]); w.w = pk2(v1[2], v1[3]);
                *(u32x4*)(G + (size_t)row * DM + (12 * BM - QKV_W) + colofs + wc * 32 + 8 * fq) = w;
            }
    }
};
constexpr int XLP = 4096;
typedef float f32x2v __attribute__((ext_vector_type(2)));
__device__ __forceinline__ unsigned pk4_bf8(float a0, float a1, float a2, float a3) {
    int w = __builtin_amdgcn_cvt_pk_bf8_f32(a0, a1, 0, false); w = __builtin_amdgcn_cvt_pk_bf8_f32(a2, a3, w, true); return (unsigned)w;
}
__device__ __forceinline__ void split_hilo(const f32x4& x0, const f32x4& x1, u32x4& hi, u32x2& lo) {
    hi.x = pk2(x0[0], x0[1]); hi.y = pk2(x0[2], x0[3]); hi.z = pk2(x1[0], x1[1]); hi.w = pk2(x1[2], x1[3]);
    lo.x = pk4_bf8(x0[0] - bflo(hi.x), x0[1] - bfhi(hi.x), x0[2] - bflo(hi.y), x0[3] - bfhi(hi.y));
    lo.y = pk4_bf8(x1[0] - bflo(hi.z), x1[1] - bfhi(hi.z), x1[2] - bflo(hi.w), x1[3] - bfhi(hi.w));
}
__device__ __forceinline__ void join_hilo(const u32x4& hi, const u32x2& lo, f32x4& x0, f32x4& x1) {
    const f32x2v a = __builtin_amdgcn_cvt_pk_f32_bf8((int)lo.x, false), b = __builtin_amdgcn_cvt_pk_f32_bf8((int)lo.x, true);
    const f32x2v c = __builtin_amdgcn_cvt_pk_f32_bf8((int)lo.y, false), d = __builtin_amdgcn_cvt_pk_f32_bf8((int)lo.y, true);
    x0[0] = bflo(hi.x) + a.x; x0[1] = bfhi(hi.x) + a.y; x0[2] = bflo(hi.y) + b.x; x0[3] = bfhi(hi.y) + b.y;
    x1[0] = bflo(hi.z) + c.x; x1[1] = bfhi(hi.z) + c.y; x1[2] = bflo(hi.w) + d.x; x1[3] = bfhi(hi.w) + d.y;
}
struct EpiOut {
    static constexpr bool PERM = true, AFTER_DRAIN = false;
    bf16_t* XB; unsigned char* XL; float* ssq;
    static constexpr int RS_KIND = 0; __device__ __forceinline__ const float* rs_ptr() const { return nullptr; } __device__ __forceinline__ float rs_inv() const { return 0.f; }
    template <bool LRS = false>
    __device__ __forceinline__ void operator()(const f32x4 (&acc)[2][2][4][2], const Unit& u, int wr, int wc, int fr, int fq, const LAS float* rst = nullptr) const {
        const int row0 = u.pm * BM + wr * 64 + fr, col0 = u.pn * BM + wc * 32 + 8 * fq;
#pragma unroll
        for (int ai = 0; ai < 2; ++ai) {
            u32x4 bh[4][2]; u32x2 bl[4][2];
#pragma unroll
            for (int m = 0; m < 4; ++m)
#pragma unroll
                for (int bj = 0; bj < 2; ++bj) {
                    const size_t r = (size_t)(row0 + ai * 128 + m * 16);
                    bh[m][bj] = *(const u32x4*)(XB + r * DM + col0 + bj * 128); bl[m][bj] = *(const u32x2*)(XL + r * XLP + col0 + bj * 128);
                }
            asm volatile("" ::: "memory");
#pragma unroll
            for (int m = 0; m < 4; ++m) {
                const size_t r = (size_t)(row0 + ai * 128 + m * 16);
                float ss = 0.f;
#pragma unroll
                for (int bj = 0; bj < 2; ++bj) {
                    f32x4 x0, x1; join_hilo(bh[m][bj], bl[m][bj], x0, x1);
                    x0 += acc[ai][bj][m][0]; x1 += acc[ai][bj][m][1];
                    u32x4 hi; u32x2 lo; split_hilo(x0, x1, hi, lo);
                    *(u32x4*)(XB + r * DM + col0 + bj * 128) = hi; *(u32x2*)(XL + r * XLP + col0 + bj * 128) = lo;
                    ss += ((x0[0] * x0[0] + x0[1] * x0[1]) + (x0[2] * x0[2] + x0[3] * x0[3])) + ((x1[0] * x1[0] + x1[1] * x1[1]) + (x1[2] * x1[2] + x1[3] * x1[3]));
                }
                ss += __shfl_xor(ss, 16); ss += __shfl_xor(ss, 32);
                if (fq == 0) ssq[r * 16 + u.pn * 4 + wc] = ss;
            }
            asm volatile("" ::: "memory");
        }
    }
};
struct EpiOutFin {
    static constexpr bool PERM = true, AFTER_DRAIN = true;
    const bf16_t* XB; const unsigned char* XL; float* out; float* ssq; unsigned* cnt; const float* fw;
    static constexpr int RS_KIND = 0; __device__ __forceinline__ const float* rs_ptr() const { return nullptr; } __device__ __forceinline__ float rs_inv() const { return 0.f; }
    __device__ __forceinline__ void fused(f32x4 (&acc)[2][2][4][2], const Unit& u, int wr, int wc, int fr, int fq, LAS unsigned char* lds, int wid, int lane) const {
        const int row0 = u.pm * BM + wr * 64 + fr, col0 = u.pn * BM + wc * 32 + 8 * fq;
#pragma unroll
        for (int ai = 0; ai < 2; ++ai) {
            u32x4 bh[4][2]; u32x2 bl[4][2];
#pragma unroll
            for (int m = 0; m < 4; ++m)
#pragma unroll
                for (int bj = 0; bj < 2; ++bj) {
                    const size_t r = (size_t)(row0 + ai * 128 + m * 16);
                    bh[m][bj] = *(const u32x4*)(XB + r * DM + col0 + bj * 128); bl[m][bj] = *(const u32x2*)(XL + r * XLP + col0 + bj * 128);
                }
            asm volatile("" ::: "memory");
#pragma unroll
            for (int m = 0; m < 4; ++m) {
                float ss = 0.f;
#pragma unroll
                for (int bj = 0; bj < 2; ++bj) {
                    f32x4 x0, x1; join_hilo(bh[m][bj], bl[m][bj], x0, x1);
                    x0 += acc[ai][bj][m][0]; x1 += acc[ai][bj][m][1];
                    acc[ai][bj][m][0] = x0; acc[ai][bj][m][1] = x1;
                    ss += ((x0[0] * x0[0] + x0[1] * x0[1]) + (x0[2] * x0[2] + x0[3] * x0[3])) + ((x1[0] * x1[0] + x1[1] * x1[1]) + (x1[2] * x1[2] + x1[3] * x1[3]));
                }
                ss += __shfl_xor(ss, 16); ss += __shfl_xor(ss, 32);
                if (fq == 0) __hip_atomic_store(ssq + (size_t)(row0 + ai * 128 + m * 16) * 16 + u.pn * 4 + wc, ss, __ATOMIC_RELAXED, __HIP_MEMORY_SCOPE_AGENT);
            }
            asm volatile("" ::: "memory");
        }
        f32x4 wv[2][2];
#pragma unroll
        for (int bj = 0; bj < 2; ++bj)
#pragma unroll
            for (int n = 0; n < 2; ++n) wv[bj][n] = *(const f32x4*)(fw + col0 + bj * 128 + n * 4);
        asm volatile("s_waitcnt vmcnt(0)" ::: "memory");
        __builtin_amdgcn_s_barrier(); asm volatile("" ::: "memory");
        if (wid == 0) {
            if (lane == 0) {
                __hip_atomic_fetch_add(cnt + 64 * u.pm, 1u, __ATOMIC_RELAXED, __HIP_MEMORY_SCOPE_AGENT);
                unsigned sp = 0;
                while (__hip_atomic_load(cnt + 64 * u.pm, __ATOMIC_RELAXED, __HIP_MEMORY_SCOPE_AGENT) < 4u) { __builtin_amdgcn_s_sleep(2); if (++sp > (1u << 22)) break; }
                __builtin_amdgcn_fence(__ATOMIC_ACQUIRE, "agent");
            }
        }
        asm volatile("s_waitcnt vmcnt(0) lgkmcnt(0)" ::: "memory");
        __builtin_amdgcn_s_barrier(); asm volatile("" ::: "memory");
        f32x4 pv[2][4];
#pragma unroll
        for (int ai = 0; ai < 2; ++ai)
#pragma unroll
            for (int m = 0; m < 4; ++m) {
                const float* sp_ = ssq + (size_t)(row0 + ai * 128 + m * 16) * 16 + 4 * fq;
#pragma unroll
                for (int e = 0; e < 4; ++e) pv[ai][m][e] = __hip_atomic_load(sp_ + e, __ATOMIC_RELAXED, __HIP_MEMORY_SCOPE_AGENT);
            }
#pragma unroll
        for (int ai = 0; ai < 2; ++ai)
#pragma unroll
            for (int m = 0; m < 4; ++m) {
                float t = (pv[ai][m][0] + pv[ai][m][1]) + (pv[ai][m][2] + pv[ai][m][3]);
                t += __shfl_xor(t, 16); t += __shfl_xor(t, 32);
                const float rs = rsqrtf(t * (1.f / 1024.f) + EPS);
#pragma unroll
                for (int bj = 0; bj < 2; ++bj)
#pragma unroll
                    for (int n = 0; n < 2; ++n)
                        *(f32x4*)(out + (size_t)(row0 + ai * 128 + m * 16) * DM + col0 + bj * 128 + n * 4) = acc[ai][bj][m][n] * rs * wv[bj][n];
            }
    }
};
struct EpiCin {
    static constexpr bool PERM = false, AFTER_DRAIN = false;
    bf16_t* CQ0; bf16_t* CKV0; bf16_t* KPE0; bf16_t* G; const float* ssq; float* ssqq; float* ssqkv; const float* rope; int pn_off, pad;
    static constexpr int RS_KIND = 16; __device__ __forceinline__ const float* rs_ptr() const { return ssq; } __device__ __forceinline__ float rs_inv() const { return 1.f / 1024.f; }
    template <bool LRS = false>
    __device__ __forceinline__ void operator()(const f32x4 (&acc)[2][2][4][2], const Unit& u, int wr, int wc, int fr, int fq, const LAS float* rst = nullptr) const {
        bf16_t* CQ = CQ0 + (long)(u.pm >> 4) * D_CQ; bf16_t* CKV = CKV0 + (long)(u.pm >> 4) * D_CKV; bf16_t* KPE = KPE0 + (long)(u.pm >> 4) * D_KPE;
        const int pn = u.pn + pn_off;
        const int row0 = u.pm * BM + wr * 64 + fr;
        float rs[2][4]; if (LRS) lds_rowscales(rst, wr, fr, 1.f, rs); else load_rowscales16(ssq, row0, fq, 1.f, rs);
        if (pn == 0) {
#pragma unroll
            for (int ai = 0; ai < 2; ++ai)
#pragma unroll
                for (int m = 0; m < 4; ++m) {
                    const int row = row0 + ai * 128 + m * 16;
                    float ss = 0.f;
#pragma unroll
                    for (int bj = 0; bj < 2; ++bj)
#pragma unroll
                        for (int n = 0; n < 2; ++n) {
                            const f32x4 v = acc[ai][bj][m][n] * rs[ai][m];
                            u32x2 w; w.x = pk2(v[0], v[1]); w.y = pk2(v[2], v[3]);
                            *(u32x2*)(CQ + (size_t)row * 256 + bj * 128 + wc * 32 + n * 16 + 4 * fq) = w;
                            ss += (v[0] * v[0] + v[1] * v[1]) + (v[2] * v[2] + v[3] * v[3]);
                        }
                    ss += __shfl_xor(ss, 16); ss += __shfl_xor(ss, 32);
                    if (fq == 0) ssqq[(size_t)row * 4 + wc] = ss;
                }
        } else if (pn == 1) {
#pragma unroll
            for (int ai = 0; ai < 2; ++ai) {
                f32x4 cs[4], sn[4];
                if (wc == 0) {
#pragma unroll
                    for (int m = 0; m < 4; ++m) { const float* rp = rope + (size_t)(row0 + ai * 128 + m * 16) * 32 + 4 * fq; cs[m] = *(const f32x4*)rp; sn[m] = *(const f32x4*)(rp + 16); }
                }
                asm volatile("" ::: "memory");
#pragma unroll
                for (int m = 0; m < 4; ++m) {
                    const int row = row0 + ai * 128 + m * 16;
                    float ss = 0.f;
#pragma unroll
                    for (int n = 0; n < 2; ++n) {
                        const f32x4 v = acc[ai][0][m][n] * rs[ai][m];
                        u32x2 w; w.x = pk2(v[0], v[1]); w.y = pk2(v[2], v[3]);
                        *(u32x2*)(CKV + (size_t)row * 128 + wc * 32 + n * 16 + 4 * fq) = w;
                        ss += (v[0] * v[0] + v[1] * v[1]) + (v[2] * v[2] + v[3] * v[3]);
                    }
                    ss += __shfl_xor(ss, 16); ss += __shfl_xor(ss, 32);
                    if (fq == 0) ssqkv[(size_t)row * 4 + wc] = ss;
                    if (wc == 0) {
                        const f32x4 t1 = acc[ai][1][m][0] * rs[ai][m], t2 = acc[ai][1][m][1] * rs[ai][m];
                        const f32x4 o1 = t1 * cs[m] - t2 * sn[m], o2 = t1 * sn[m] + t2 * cs[m];
                        u32x2 w1, w2; w1.x = pk2(o1[0], o1[1]); w1.y = pk2(o1[2], o1[3]); w2.x = pk2(o2[0], o2[1]); w2.y = pk2(o2[2], o2[3]);
                        *(u32x2*)(KPE + (size_t)row * 32 + 4 * fq) = w1;
                        *(u32x2*)(KPE + (size_t)row * 32 + 16 + 4 * fq) = w2;
                    }
                }
                asm volatile("" ::: "memory");
            }
        } else {
#pragma unroll
            for (int ai = 0; ai < 2; ++ai)
#pragma unroll
                for (int m = 0; m < 4; ++m) {
                    const int row = row0 + ai * 128 + m * 16;
#pragma unroll
                    for (int bj = 0; bj < 2; ++bj)
#pragma unroll
                        for (int n = 0; n < 2; ++n) {
                            const f32x4 v = acc[ai][bj][m][n] * rs[ai][m];
                            u32x2 w; w.x = pk2(silu_f(v[0]), silu_f(v[1])); w.y = pk2(silu_f(v[2]), silu_f(v[3]));
                            *(u32x2*)(G + (size_t)row * DM + (pn - 2) * BM + bj * 128 + wc * 32 + n * 16 + 4 * fq) = w;
                        }
                }
        }
    }
};
struct EpiQ {
    static constexpr bool PERM = false, AFTER_DRAIN = false;
    bf16_t* Q0; const float* ssqq; const float* rope;
    static constexpr int RS_KIND = 4; __device__ __forceinline__ const float* rs_ptr() const { return ssqq; } __device__ __forceinline__ float rs_inv() const { return 1.f / 256.f; }
    template <bool LRS = false>
    __device__ __forceinline__ void operator()(const f32x4 (&acc)[2][2][4][2], const Unit& u, int wr, int wc, int fr, int fq, const LAS float* rst = nullptr) const {
        bf16_t* Q = Q0 + (long)(u.pm >> 4) * D_Q;
        const int pn = u.pn;
        const int row0 = u.pm * BM + wr * 64 + fr;
        float rq[2][4]; if (LRS) lds_rowscales(rst, wr, fr, CQ_C, rq); else load_rowscales4(ssqq, row0, 1.f / 256.f, CQ_C, rq);
        if (pn < 4) {
#pragma unroll
            for (int ai = 0; ai < 2; ++ai)
#pragma unroll
                for (int m = 0; m < 4; ++m) {
                    const int row = row0 + ai * 128 + m * 16;
#pragma unroll
                    for (int bj = 0; bj < 2; ++bj)
#pragma unroll
                        for (int n = 0; n < 2; ++n) {
                            const f32x4 v = acc[ai][bj][m][n] * rq[ai][m];
                            const int col = pn * BM + bj * 128 + wc * 32 + n * 16 + 4 * fq, h = col >> 6, d = col & 63;
                            u32x2 w; w.x = pk2(v[0], v[1]); w.y = pk2(v[2], v[3]);
                            *(u32x2*)(Q + (size_t)row * 1536 + h * 96 + d) = w;
                        }
                }
        } else {
#pragma unroll
            for (int ai = 0; ai < 2; ++ai) {
                f32x4 cs[4], sn[4];
#pragma unroll
                for (int m = 0; m < 4; ++m) { const float* rp = rope + (size_t)(row0 + ai * 128 + m * 16) * 32 + 4 * fq; cs[m] = *(const f32x4*)rp; sn[m] = *(const f32x4*)(rp + 16); }
                asm volatile("" ::: "memory");
#pragma unroll
                for (int m = 0; m < 4; ++m) {
                    const int row = row0 + ai * 128 + m * 16;
#pragma unroll
                    for (int bj = 0; bj < 2; ++bj) {
                        const int h = 8 * (pn - 4) + 4 * bj + wc;
                        const f32x4 t1 = acc[ai][bj][m][0] * rq[ai][m], t2 = acc[ai][bj][m][1] * rq[ai][m];
                        const f32x4 o1 = t1 * cs[m] - t2 * sn[m], o2 = t1 * sn[m] + t2 * cs[m];
                        u32x2 w1, w2; w1.x = pk2(o1[0], o1[1]); w1.y = pk2(o1[2], o1[3]); w2.x = pk2(o2[0], o2[1]); w2.y = pk2(o2[2], o2[3]);
                        *(u32x2*)(Q + (size_t)row * 1536 + h * 96 + 64 + 4 * fq) = w1;
                        *(u32x2*)(Q + (size_t)row * 1536 + h * 96 + 80 + 4 * fq) = w2;
                    }
                }
                asm volatile("" ::: "memory");
            }
        }
    }
};
struct EpiKV {
    static constexpr bool PERM = true, AFTER_DRAIN = false;
    bf16_t* K0; bf16_t* V0; const float* ssqkv;
    static constexpr int RS_KIND = 4; __device__ __forceinline__ const float* rs_ptr() const { return ssqkv; } __device__ __forceinline__ float rs_inv() const { return 1.f / 128.f; }
    template <bool LRS = false>
    __device__ __forceinline__ void operator()(const f32x4 (&acc)[2][2][4][2], const Unit& u, int wr, int wc, int fr, int fq, const LAS float* rst = nullptr) const {
        bf16_t* K = K0 + (long)(u.pm >> 4) * D_KV; bf16_t* V = V0 + (long)(u.pm >> 4) * D_KV;
        const int row0 = u.pm * BM + wr * 64 + fr;
        float rk[2][4]; if (LRS) lds_rowscales(rst, wr, fr, 1.f, rk); else load_rowscales4(ssqkv, row0, 1.f / 128.f, 1.f, rk);
#pragma unroll
        for (int ai = 0; ai < 2; ++ai)
#pragma unroll
            for (int m = 0; m < 4; ++m) {
                const int row = row0 + ai * 128 + m * 16;
#pragma unroll
                for (int bj = 0; bj < 2; ++bj) {
                    const int h = 2 * u.pn + bj, cc = wc * 32 + 8 * fq;
                    const f32x4 v0 = acc[ai][bj][m][0] * rk[ai][m], v1 = acc[ai][bj][m][1] * rk[ai][m];
                    u32x4 w; w.x = pk2(v0[0], v0[1]); w.y = pk2(v0[2], v0[3]); w.z = pk2(v1[0], v1[1]); w.w = pk2(v1[2], v1[3]);
                    if (wc < 2) *(u32x4*)(K + (size_t)row * 1024 + h * 64 + cc) = w;
                    else *(u32x4*)(V + (size_t)row * 1024 + h * 64 + (cc - 64)) = w;
                }
            }
    }
};

template <class Epi>
__global__ __launch_bounds__(256) void naive_gemm_k(Gemm g, Epi E) {
    const int tid = threadIdx.x, wc = tid >> 6, lane = tid & 63, fr = lane & 15, fq = lane >> 4;
    const int K = g.K, nN = g.N / BM, nhu = 2 * (g.M / BM) * nN;
    for (int hu = blockIdx.x; hu < nhu; hu += gridDim.x) {
        const int wr = hu & 1; Unit u; u.pm = (hu >> 1) / nN; u.pn = (hu >> 1) % nN;
        f32x4 acc[2][2][4][2];
#pragma unroll
        for (int a = 0; a < 2; ++a)
#pragma unroll
            for (int b = 0; b < 2; ++b)
#pragma unroll
                for (int m = 0; m < 4; ++m)
#pragma unroll
                    for (int n = 0; n < 2; ++n) acc[a][b][m][n] = (f32x4){0.f, 0.f, 0.f, 0.f};
        const bf16_t* Ab = g.A + (size_t)(u.pm * BM + wr * 64 + fr) * K + (long)(u.pm >> 4) * (g.pad / 2);
        const bf16_t* Bb = g.Bt + (size_t)(u.pn * BM + wc * 32) * K;
#pragma unroll 1
        for (int k0 = 0; k0 < K; k0 += 8) {
#pragma unroll
            for (int ai = 0; ai < 2; ++ai) {
                bf16x8 a[4];
#pragma unroll
                for (int m = 0; m < 4; ++m) a[m] = *(const bf16x8*)(Ab + (size_t)(ai * 128 + m * 16) * K + k0);
#pragma unroll
                for (int bj = 0; bj < 2; ++bj)
#pragma unroll
                    for (int n = 0; n < 2; ++n)
#pragma unroll
                        for (int e = 0; e < 4; ++e) {
                            const int cw = Epi::PERM ? (8 * fq + 4 * n + e) : (16 * n + 4 * fq + e);
                            const bf16x8 b = *(const bf16x8*)(Bb + (size_t)(bj * 128 + cw) * K + k0);
#pragma unroll
                            for (int m = 0; m < 4; ++m) acc[ai][bj][m][n][e] = dot8(a[m], b, acc[ai][bj][m][n][e]);
                        }
            }
        }
        E(acc, u, wr, wc, fr, fq);
    }
}

#define PG8_LAS __attribute__((address_space(3)))
constexpr int BK = 64, HALF = 128, HTB = HALF * BK * 2, STAGE_BYTES = 8 * HTB;
__host__ __device__ __forceinline__ int lds_byte(int r, int c) { const int st = (r >> 4) * 2 + (c >> 5), rr = r & 15, cc = c & 31, ob = rr * 64 + cc * 2; return st * 1024 + (ob ^ (((ob >> 9) & 1) << 5)); }
__host__ __device__ __forceinline__ void stage_rc(int b, int& R, int& C) { const int st = b / 1024, sb = b % 1024, swz = sb ^ (((sb >> 9) & 1) << 5); R = (st >> 1) * 16 + swz / 64; C = (st & 1) * 32 + (swz % 64) / 2; }
__host__ __device__ __forceinline__ int perm32(int rho) { const int n = rho >> 4, i = rho & 15; return 8 * (i >> 2) + 4 * n + (i & 3); }
template <class Epi, class Sched, bool ALIGN_EPI = false, bool SP2 = false, bool HALFN = false>
__device__ __forceinline__ void gemm_phase(PG8_LAS unsigned char* lds, const Gemm g, const Sched& S, const Epi& E, int wave_s) {
    int tid_ = wave_s * 64 + lane_id(); asm volatile("" : "+v"(tid_));
    const int tid = tid_, wid = __builtin_amdgcn_readfirstlane(tid >> 6), lane = tid & 63, wr = wid >> 2, wc = wid & 3, fr = lane & 15, fq = lane >> 4;
    const int K = g.K, nt = K / BK;
    unsigned voffA[2], voffB[2];
#pragma unroll
    for (int i = 0; i < 2; ++i) { int R, C; stage_rc(tid * 16 + i * 8192, R, C); const int Rb = Epi::PERM ? ((R & ~31) + perm32(R & 31)) : R;
        voffA[i] = (unsigned)(R * K + C) * 2u; voffB[i] = (unsigned)(Rb * K + C) * 2u; }
    const size_t kstep = (size_t)(BK * 2);
    const size_t hstep = (size_t)HALF * K * 2;
    const size_t tstep = 2 * hstep;
    const unsigned ldsw = (unsigned)wid * 1024u;
    const int aoff = lds_byte(wr * 64 + fr, fq * 8), boff = lds_byte(wc * 32 + fr, fq * 8);
#define PG8_SA(b, h) (((b) * 2 + (h)) * HTB)
#define PG8_SB(b, h) ((4 + (b) * 2 + (h)) * HTB)
#define PG8_STAGE(bufoff, gbase, voff) do { _Pragma("unroll") for (int _i = 0; _i < 2; ++_i) \
        __builtin_amdgcn_global_load_lds((const unsigned*)((const char*)(gbase) + (voff)[_i]), (PG8_LAS unsigned*)(lds + (bufoff) + ldsw + _i * 8192), 16, 0, 0); } while (0)
#define PG8_LDA(dst, b, h) do { _Pragma("unroll") for (int m = 0; m < 4; ++m) _Pragma("unroll") for (int k = 0; k < 2; ++k) dst[m][k] = *(const PG8_LAS bf16x8*)(lds + PG8_SA(b, h) + aoff + m * 2048 + k * 1024); } while (0)
#define PG8_LDB(dst, b, h) do { _Pragma("unroll") for (int n = 0; n < 2; ++n) _Pragma("unroll") for (int k = 0; k < 2; ++k) dst[n][k] = *(const PG8_LAS bf16x8*)(lds + PG8_SB(b, h) + boff + n * 2048 + k * 1024); } while (0)
#define PG8_MMA(ai, bj, At, Bt) do { __builtin_amdgcn_s_setprio(1); _Pragma("unroll") for (int m = 0; m < 4; ++m) _Pragma("unroll") for (int n = 0; n < 2; ++n) _Pragma("unroll") for (int k = 0; k < 2; ++k) \
        acc[ai][bj][m][n] = __builtin_amdgcn_mfma_f32_16x16x32_bf16(Bt[n][k], At[m][k], acc[ai][bj][m][n], 0, 0, 0); __builtin_amdgcn_s_setprio(0); } while (0)
#define PG8_WAIT_V(n) asm volatile("s_waitcnt vmcnt(" #n ")" ::: "memory")
#define PG8_WAIT_L(n) asm volatile("s_waitcnt lgkmcnt(" #n ")" ::: "memory")
#define PG8_BAR __builtin_amdgcn_s_barrier()
#define PG8_SCHED __builtin_amdgcn_sched_barrier(0)
    Unit cur, nxt; int ui = 0;
    if (!S.next(0, cur)) return;
    f32x4 acc[2][2][4][2];
#pragma unroll
    for (int a = 0; a < 2; ++a)
#pragma unroll
        for (int b = 0; b < 2; ++b)
#pragma unroll
            for (int m = 0; m < 4; ++m)
#pragma unroll
                for (int n = 0; n < 2; ++n) acc[a][b][m][n] = (f32x4){0.f, 0.f, 0.f, 0.f};
    bf16x8 At[4][2], B0[2][2], B1[2][2];
    const char* cA = (const char*)g.A + (size_t)cur.pm * tstep + (long)(cur.pm >> 4) * g.pad; const char* cB = (const char*)g.Bt + (size_t)cur.pn * tstep;
    S.a_ready(cur);
    constexpr int RS_MAXU = 8, RS_Q = (Epi::RS_KIND == 16) ? 4 : 1;
    unsigned rs_off_ = 8 * HTB; asm volatile("" : "+s"(rs_off_));
    PG8_LAS float* rst = (PG8_LAS float*)(lds + rs_off_);
    f32x4 rsv[RS_MAXU / 2][RS_Q]; bool rsok[RS_MAXU / 2];
    if constexpr (Epi::RS_KIND != 0) {
        const float* rsrc = E.rs_ptr(); const int r_ = tid & 255, jp_ = tid >> 8;
#pragma unroll
        for (int jj = 0; jj < RS_MAXU / 2; ++jj) { Unit uu; rsok[jj] = S.next(jp_ + 2 * jj, uu);
            if (rsok[jj]) { const float* pr = rsrc + (size_t)(uu.pm * BM + r_) * Epi::RS_KIND;
#pragma unroll
                for (int q = 0; q < RS_Q; ++q) rsv[jj][q] = *(const f32x4*)(pr + 4 * q); } }
        asm volatile("" ::: "memory");
    }
#define RS_COMBINE() do { if constexpr (Epi::RS_KIND != 0) { PG8_WAIT_V(8); const float inv_ = E.rs_inv(); const int r_ = tid & 255, jp_ = tid >> 8; \
        _Pragma("unroll") for (int jj = 0; jj < RS_MAXU / 2; ++jj) if (rsok[jj]) { f32x4 t_ = rsv[jj][0]; _Pragma("unroll") for (int q = 1; q < RS_Q; ++q) t_ += rsv[jj][q]; \
            rst[(jp_ + 2 * jj) * 256 + r_] = rsqrtf(((t_[0] + t_[1]) + (t_[2] + t_[3])) * inv_ + EPS); } } } while (0)
    if constexpr (SP2) {
        PG8_STAGE(PG8_SB(0, 0), cB, voffB); PG8_STAGE(PG8_SB(0, 1), cB + hstep, voffB); PG8_STAGE(PG8_SA(0, 0), cA, voffA); PG8_STAGE(PG8_SA(0, 1), cA + hstep, voffA);
        RS_COMBINE();
        if (wr == 1) PG8_BAR;
        PG8_WAIT_V(2); PG8_BAR;
        PG8_STAGE(PG8_SB(1, 0), cB + kstep, voffB); PG8_STAGE(PG8_SA(1, 0), cA + kstep, voffA); PG8_STAGE(PG8_SB(1, 1), cB + hstep + kstep, voffB);
        PG8_WAIT_V(6); PG8_BAR;
    } else {
        PG8_STAGE(PG8_SB(0, 0), cB, voffB); PG8_STAGE(PG8_SA(0, 0), cA, voffA); PG8_STAGE(PG8_SB(0, 1), cB + hstep, voffB); PG8_STAGE(PG8_SA(0, 1), cA + hstep, voffA);
        RS_COMBINE();
        if (wr == 1) PG8_BAR;
        PG8_WAIT_V(4); PG8_BAR;
        PG8_STAGE(PG8_SB(1, 0), cB + kstep, voffB); PG8_STAGE(PG8_SA(1, 0), cA + kstep, voffA); PG8_STAGE(PG8_SB(1, 1), cB + hstep + kstep, voffB);
        PG8_WAIT_V(6); PG8_BAR;
    }
    for (;;) {
        const bool has_next = S.next(ui + 1, nxt);
        const char* nA = has_next ? (const char*)g.A + (size_t)nxt.pm * tstep + (long)(nxt.pm >> 4) * g.pad : cA; const char* nB = has_next ? (const char*)g.Bt + (size_t)nxt.pn * tstep : cB;
        for (int t = 0; t < nt; t += 2) {
            const bool last = (t == nt - 2);
            const char* a1 = cA + (size_t)(t + 1) * kstep;
            const char* a2 = last ? nA : cA + (size_t)(t + 2) * kstep; const char* b2 = last ? nB : cB + (size_t)(t + 2) * kstep;
            const char* a3 = a2 + kstep; const char* b3 = b2 + kstep;
            if (last && has_next) S.a_ready(nxt);
            if constexpr (SP2) {
            PG8_LDB(B0, 0, 0); if constexpr (!HALFN) PG8_LDB(B1, 0, 1); PG8_SCHED; PG8_LDA(At, 0, 0); PG8_STAGE(PG8_SA(1, 1), a1 + hstep, voffA);
            PG8_WAIT_V(8); PG8_WAIT_L(0); PG8_BAR; PG8_MMA(0, 0, At, B0); if constexpr (!HALFN) PG8_MMA(0, 1, At, B1); PG8_BAR; PG8_SCHED;
            PG8_LDA(At, 0, 1); PG8_STAGE(PG8_SB(0, 0), b2, voffB); PG8_STAGE(PG8_SB(0, 1), b2 + hstep, voffB); PG8_STAGE(PG8_SA(0, 0), a2, voffA);
            PG8_WAIT_V(8); PG8_WAIT_L(0); PG8_BAR; PG8_MMA(1, 0, At, B0); if constexpr (!HALFN) PG8_MMA(1, 1, At, B1); PG8_BAR; PG8_SCHED;
            PG8_LDB(B0, 1, 0); if constexpr (!HALFN) PG8_LDB(B1, 1, 1); PG8_SCHED; PG8_LDA(At, 1, 0); PG8_STAGE(PG8_SA(0, 1), a2 + hstep, voffA);
            PG8_WAIT_V(8); PG8_WAIT_L(0); PG8_BAR; PG8_MMA(0, 0, At, B0); if constexpr (!HALFN) PG8_MMA(0, 1, At, B1); PG8_BAR; PG8_SCHED;
            PG8_LDA(At, 1, 1); PG8_STAGE(PG8_SB(1, 0), b3, voffB); PG8_STAGE(PG8_SB(1, 1), b3 + hstep, voffB); PG8_STAGE(PG8_SA(1, 0), a3, voffA);
            PG8_WAIT_V(8); PG8_WAIT_L(0); PG8_BAR; PG8_MMA(1, 0, At, B0); if constexpr (!HALFN) PG8_MMA(1, 1, At, B1); PG8_BAR; PG8_SCHED;
            } else {
            PG8_LDB(B0, 0, 0); PG8_SCHED; PG8_LDA(At, 0, 0); PG8_STAGE(PG8_SA(1, 1), a1 + hstep, voffA);
            PG8_WAIT_L(8); PG8_BAR; PG8_WAIT_L(0); PG8_MMA(0, 0, At, B0); PG8_BAR; PG8_SCHED;
            PG8_LDB(B1, 0, 1); PG8_STAGE(PG8_SB(0, 0), b2, voffB);
            PG8_BAR; PG8_WAIT_L(0); PG8_MMA(0, 1, At, B1); PG8_BAR;
            PG8_LDA(At, 0, 1); PG8_STAGE(PG8_SA(0, 0), a2, voffA);
            PG8_BAR; PG8_WAIT_L(0); PG8_MMA(1, 0, At, B0); PG8_BAR; PG8_SCHED;
            PG8_STAGE(PG8_SB(0, 1), b2 + hstep, voffB);
            PG8_WAIT_V(6); PG8_BAR; PG8_MMA(1, 1, At, B1); PG8_BAR;
            PG8_LDB(B0, 1, 0); PG8_SCHED; PG8_LDA(At, 1, 0); PG8_STAGE(PG8_SA(0, 1), a2 + hstep, voffA);
            PG8_WAIT_L(8); PG8_BAR; PG8_WAIT_L(0); PG8_MMA(0, 0, At, B0); PG8_BAR; PG8_SCHED;
            PG8_LDB(B1, 1, 1); PG8_STAGE(PG8_SB(1, 0), b3, voffB);
            PG8_BAR; PG8_WAIT_L(0); PG8_MMA(0, 1, At, B1); PG8_BAR;
            PG8_LDA(At, 1, 1); PG8_STAGE(PG8_SA(1, 0), a3, voffA);
            PG8_BAR; PG8_WAIT_L(0); PG8_MMA(1, 0, At, B0); PG8_BAR; PG8_SCHED;
            PG8_STAGE(PG8_SB(1, 1), b3 + hstep, voffB);
            PG8_WAIT_V(6); PG8_BAR; PG8_MMA(1, 1, At, B1); PG8_BAR;
            }
        }
        if constexpr (ALIGN_EPI) { if (wr == 0) PG8_BAR; }
        if constexpr (!Epi::AFTER_DRAIN) { const int le_ = lane_id(); E.template operator()<true>(acc, cur, wr, wc, le_ & 15, le_ >> 4, rst + ui * 256); S.done(cur); }
        if (!has_next) break;
#pragma unroll
        for (int a = 0; a < 2; ++a)
#pragma unroll
            for (int b = 0; b < 2; ++b)
#pragma unroll
                for (int m = 0; m < 4; ++m)
#pragma unroll
                    for (int n = 0; n < 2; ++n) acc[a][b][m][n] = (f32x4){0.f, 0.f, 0.f, 0.f};
        cur = nxt; cA = nA; cB = nB; ++ui;
        if constexpr (ALIGN_EPI) { if (wr == 1) PG8_BAR; }
    }
    PG8_WAIT_V(0);
    if constexpr (!ALIGN_EPI) { if (wr == 0) PG8_BAR; }
    PG8_BAR;
    if constexpr (Epi::AFTER_DRAIN) { E.fused(acc, cur, wr, wc, fr, fq, lds, wid, lane); S.done(cur); }
#undef RS_COMBINE
#undef PG8_SA
#undef PG8_SB
#undef PG8_STAGE
#undef PG8_LDA
#undef PG8_LDB
#undef PG8_MMA
#undef PG8_WAIT_V
#undef PG8_WAIT_L
#undef PG8_BAR
#undef PG8_SCHED
}


struct ConvItem { const float* W; const float* kscale; bf16_t* WT; int K, N, srcn0, dstn0, k0; };
__device__ __forceinline__ void conv_load(const ConvItem& c, f32x4 (&v)[8], f32x4& ks0, f32x4& ks1, int lane) {
    const int c8 = lane & 7, r8 = lane >> 3;
    if (c.srcn0 >= 0) {
        const float* p = c.W + (size_t)(c.k0 + r8) * c.N + c.srcn0 + 4 * c8;
#pragma unroll
        for (int r = 0; r < 8; ++r) v[r] = __builtin_nontemporal_load((const f32x4*)(p + (size_t)(8 * r) * c.N));
    } else {
#pragma unroll
        for (int r = 0; r < 8; ++r) v[r] = (f32x4){0.f, 0.f, 0.f, 0.f};
    }
    ks0 = (f32x4){1.f, 1.f, 1.f, 1.f}; ks1 = ks0;
    if (c.kscale) { ks0 = *(const f32x4*)(c.kscale + c.k0 + 8 * c8); ks1 = *(const f32x4*)(c.kscale + c.k0 + 8 * c8 + 4); }
}
struct ConvOut { bf16_t* p; int K; };
__device__ __forceinline__ void conv_finish(const ConvOut& c, const f32x4 (&v)[8], const f32x4& ks0, const f32x4& ks1, LAS float* scr, int lane) {
    const int c8 = lane & 7, r8 = lane >> 3;
#pragma unroll
    for (int r = 0; r < 8; ++r) {
        LAS float* d = scr + (8 * r + r8) * 33 + 4 * c8;
        d[0] = v[r][0]; d[1] = v[r][1]; d[2] = v[r][2]; d[3] = v[r][3];
    }
    asm volatile("s_waitcnt lgkmcnt(0)" ::: "memory");
#pragma unroll
    for (int j = 0; j < 4; ++j) {
        const int n = r8 + 8 * j; const LAS float* s = scr + (8 * c8) * 33 + n;
        u32x4 o; o.x = pk2(s[0 * 33] * ks0[0], s[1 * 33] * ks0[1]); o.y = pk2(s[2 * 33] * ks0[2], s[3 * 33] * ks0[3]); o.z = pk2(s[4 * 33] * ks1[0], s[5 * 33] * ks1[1]); o.w = pk2(s[6 * 33] * ks1[2], s[7 * 33] * ks1[3]);
        *(u32x4*)(c.p + (size_t)n * c.K + 8 * c8) = o;
    }
    asm volatile("s_waitcnt lgkmcnt(0)" ::: "memory");
}

struct Args {
    const float* x; const int* pos; const float* norm_w; const float* rel_bias; const float* ab_w_in; const float* ab_sinks; const float* ab_w_out;
    const float* c_w_in; const float* c_q_norm; const float* c_w_qb; const float* c_kv_norm; const float* c_w_kvb; const float* c_w_out; const float* final_norm;
    float* out; unsigned char* ws; int ph_lo, ph_hi;
};

__device__ __forceinline__ int t5_bucket(int dist) {
    if (dist < 16) return dist;
    int large = 16 + (int)(logf((float)dist / 16.f) / logf(128.f) * 16.f);
    return large < 31 ? large : 31;
}

template <int PART>
__device__ __forceinline__ void prologue(const Args& a, LAS unsigned char* lds, int gw, int NGW, int lane, int wave) {
    unsigned char* ws = a.ws;
    LAS float* scr = (LAS float*)(lds + wave * 16384);
    constexpr int I_ABIN = 16 * (AB_IN / 32), I_SQ = 16 * 32, I_CIN = 16 * (C_INP / 32), I_CQB = 4 * 48, I_CKVB = 2 * 64;
    constexpr int PER = I_ABIN + I_SQ + I_CIN + I_CQB + I_CKVB + I_SQ;
    constexpr int IT_LO = (PART == 0) ? 0 : (PART == 2) ? PER + I_ABIN : I_ABIN, IT_HI = (PART == 0) ? I_ABIN : (PART == 1) ? PER + I_ABIN : 2 * PER;
    auto item_of = [&](int it) -> ConvItem {
        const int li = it / PER; int r = it % PER;
        if (r < I_ABIN) { const int nb = AB_IN / 32, kb = r / nb, n0 = (r % nb) * 32;
            return ConvItem{a.ab_w_in + (size_t)li * DM * AB_IN, a.norm_w + (2 * li) * DM, (bf16_t*)(ws + W_ABIN) + (size_t)li * AB_IN * DM, DM, AB_IN, n0, n0, kb * 64}; }
        r -= I_ABIN;
        if (r < I_SQ) { const int kb = r / 32, n0 = (r % 32) * 32;
            return ConvItem{a.ab_w_out + (size_t)li * DM * DM, nullptr, (bf16_t*)(ws + W_ABOUT) + (size_t)li * DM * DM, DM, DM, n0, n0, kb * 64}; }
        r -= I_SQ;
        if (r < I_CIN) { const int nb = C_INP / 32, kb = r / nb, n0 = (r % nb) * 32;
            const int src = (n0 < 416) ? n0 : ((n0 < 512) ? -1 : n0 - 96);
            return ConvItem{a.c_w_in + (size_t)li * DM * C_IN, a.norm_w + (2 * li + 1) * DM, (bf16_t*)(ws + W_CIN) + (size_t)li * C_INP * DM, DM, C_IN, src, n0, kb * 64}; }
        r -= I_CIN;
        if (r < I_CQB) { const int kb = r / 48, n0 = (r % 48) * 32;
            const int src = (n0 < 1024) ? ((n0 >> 6) * 96 + (n0 & 63)) : (((n0 - 1024) >> 5) * 96 + 64);
            return ConvItem{a.c_w_qb + (size_t)li * 256 * 1536, a.c_q_norm + li * 256, (bf16_t*)(ws + W_CQB) + (size_t)li * 1536 * 256, 256, 1536, src, n0, kb * 64}; }
        r -= I_CQB;
        if (r < I_CKVB) { const int kb = r / 64, n0 = (r % 64) * 32;
            return ConvItem{a.c_w_kvb + (size_t)li * 128 * 2048, a.c_kv_norm + li * 128, (bf16_t*)(ws + W_CKVB) + (size_t)li * 2048 * 128, 128, 2048, n0, n0, kb * 64}; }
        r -= I_CKVB;
        { const int kb = r / 32, n0 = (r % 32) * 32;
            return ConvItem{a.c_w_out + (size_t)li * DM * DM, nullptr, (bf16_t*)(ws + W_COUT) + (size_t)li * DM * DM, DM, DM, n0, n0, kb * 64}; }
    };
    f32x4 nx[4]; int npos = 0;
    if (PART == 0) { if (gw < T) {
#pragma unroll
        for (int j = 0; j < 4; ++j) nx[j] = __builtin_nontemporal_load((const f32x4*)(a.x + (size_t)gw * DM) + lane + 64 * j);
        npos = a.pos[gw];
    } }
    {
        ConvOut oa{nullptr, 0}; f32x4 va[8], ka0, ka1; bool have = false;
#pragma unroll 1
        for (int it = IT_LO + gw;; it += NGW) {
            const bool hn = it < IT_HI;
            ConvOut ob{nullptr, 0}; f32x4 vb[8], kb0, kb1;
            if (hn) { const ConvItem c = item_of(it); conv_load(c, vb, kb0, kb1, lane); ob = ConvOut{c.WT + (size_t)c.dstn0 * c.K + c.k0, c.K}; }
            if (have) conv_finish(oa, va, ka0, ka1, scr, lane);
            if (!hn) break;
#pragma unroll
            for (int r = 0; r < 8; ++r) va[r] = vb[r];
            ka0 = kb0; ka1 = kb1; oa = ob; have = true;
        }
    }
    if (PART != 0) return;
    bf16_t* XB = (bf16_t*)(ws + WS_XB); float* ssq = (float*)(ws + WS_SSQ); float* rope = (float*)(ws + WS_ROPE);
    auto do_row = [&](int row, const f32x4 (&v4)[4], int pos) {
        float s = 0.f;
#pragma unroll
        for (int j = 0; j < 4; ++j) {
            const f32x4 v = v4[j];
            s += (v[0] * v[0] + v[1] * v[1]) + (v[2] * v[2] + v[3] * v[3]);
            u32x2 w; w.x = pk2(v[0], v[1]); w.y = pk2(v[2], v[3]);
            const unsigned wl = pk4_bf8(v[0] - bflo(w.x), v[1] - bfhi(w.x), v[2] - bflo(w.y), v[3] - bfhi(w.y));
            *((u32x2*)(XB + (size_t)row * DM) + lane + 64 * j) = w;
            *((unsigned*)((unsigned char*)a.out + (size_t)row * XLP) + lane + 64 * j) = wl;
        }
        s = wave_sum(s);
        if (lane < 16) ssq[(size_t)row * 16 + lane] = (lane == 0) ? s : 0.f;
        if (lane < 32) {
            const int i = lane & 15;
            const float inv_freq = exp2f(-(float)(2 * i) / 32.f * 13.287712379549449f);
            const float ang = (float)pos * inv_freq;
            rope[(size_t)row * 32 + lane] = (lane < 16) ? cosf(ang) : sinf(ang);
        }
    };
    f32x4 nb[4]; int nposb = 0;
    if (gw + NGW < T) {
#pragma unroll
        for (int j = 0; j < 4; ++j) nb[j] = __builtin_nontemporal_load((const f32x4*)(a.x + (size_t)(gw + NGW) * DM) + lane + 64 * j);
        nposb = a.pos[gw + NGW];
    }
    for (int row = gw; row < T; row += 2 * NGW) {
        f32x4 v4[4]; int pos = npos;
#pragma unroll
        for (int j = 0; j < 4; ++j) v4[j] = nx[j];
        if (row + 2 * NGW < T) {
#pragma unroll
            for (int j = 0; j < 4; ++j) nx[j] = __builtin_nontemporal_load((const f32x4*)(a.x + (size_t)(row + 2 * NGW) * DM) + lane + 64 * j);
            npos = a.pos[row + 2 * NGW];
        }
        asm volatile("" ::: "memory");
        do_row(row, v4, pos);
        if (row + NGW < T) {
            pos = nposb;
#pragma unroll
            for (int j = 0; j < 4; ++j) v4[j] = nb[j];
            if (row + 3 * NGW < T) {
#pragma unroll
                for (int j = 0; j < 4; ++j) nb[j] = __builtin_nontemporal_load((const f32x4*)(a.x + (size_t)(row + 3 * NGW) * DM) + lane + 64 * j);
                nposb = a.pos[row + 3 * NGW];
            }
            asm volatile("" ::: "memory");
            do_row(row + NGW, v4, pos);
        }
    }
    float* bt = (float*)(ws + WS_BT);
    for (int i = gw * 64 + lane; i < 4 * 8 * 192; i += NGW * 64) {
        const int cfg = i / (8 * 192), h = (i / 192) % 8, delta = i % 192 - 31;
        const int dil = (cfg <= 1) ? 1 : ((cfg == 2) ? 4 : 16);
        float v = -INFINITY;
        if (delta >= 0 && delta <= 128) v = a.rel_bias[t5_bucket(delta * dil) * 16 + (cfg == 0 ? h : 8 + h)] * LOG2E;
        bt[i] = v;
    }
}

__device__ __forceinline__ void final_norm_phase(const Args& a, int gw, int NGW, int lane) {
    const float* ssq = (const float*)(a.ws + WS_SSQ); const bf16_t* XB = (const bf16_t*)(a.ws + WS_XB); const unsigned char* XL = (const unsigned char*)a.out;
    for (int row = gw; row < T; row += NGW) {
        const float rs = rowscale16(ssq, row);
        u32x2 h[4]; unsigned l[4];
#pragma unroll
        for (int j = 0; j < 4; ++j) { h[j] = *((const u32x2*)(XB + (size_t)row * DM) + lane + 64 * j); l[j] = *((const unsigned*)(XL + (size_t)row * XLP) + lane + 64 * j); }
        asm volatile("" ::: "memory");
        f32x4* xr = (f32x4*)(a.out + (size_t)row * DM) + lane;
        const f32x4* wv = (const f32x4*)a.final_norm + lane;
#pragma unroll
        for (int j = 0; j < 4; ++j) { const f32x2v la = __builtin_amdgcn_cvt_pk_f32_bf8((int)l[j], false), lb = __builtin_amdgcn_cvt_pk_f32_bf8((int)l[j], true);
            f32x4 v; v[0] = bflo(h[j].x) + la.x; v[1] = bfhi(h[j].x) + la.y; v[2] = bflo(h[j].y) + lb.x; v[3] = bfhi(h[j].y) + lb.y;
            xr[64 * j] = v * rs * wv[64 * j]; }
    }
}

typedef float f32x16 __attribute__((ext_vector_type(16)));
typedef short s16x4 __attribute__((ext_vector_type(4)));

namespace mla2 {
constexpr int KSLOT = 12288, VSLOT = 8192;
constexpr int L_K = 0, L_V = 3 * KSLOT, L_WS = L_V + 3 * VSLOT, L_OST = L_WS + 8 * 256, L_QS = L_OST + 8 * 4096, L_END = L_QS + 8 * 6144;
constexpr int THRL = 8;
typedef __attribute__((address_space(3))) const char* lds_cptr;
typedef short v4i16_t __attribute__((ext_vector_type(4)));
#define SBAR() __builtin_amdgcn_sched_barrier(0)
#define WAIT_BAR(N) asm volatile("s_waitcnt vmcnt(" #N ") lgkmcnt(0)\n\ts_barrier" ::: "memory")
__device__ __forceinline__ int crow(int r, int hi) { return (r & 3) + 8 * (r >> 2) + 4 * hi; }
__device__ __forceinline__ void glds16(const void* sbase, unsigned voff, unsigned lds_dst) { unsigned keep;
    asm volatile("s_mov_b32 %0, m0\n\ts_mov_b32 m0, %2\n\ts_nop 0\n\tglobal_load_lds_dwordx4 %1, %3\n\ts_mov_b32 m0, %0" : "=&s"(keep) : "v"(voff), "s"(lds_dst), "s"(sbase) : "memory"); }
__device__ __forceinline__ s16x4 vtr(lds_cptr p) { return __builtin_bit_cast(s16x4, __builtin_amdgcn_ds_read_tr16_b64_v4i16((__attribute__((address_space(3))) v4i16_t*)p)); }
__device__ __forceinline__ void cmask(f32x16& p0, f32x16& p1, int jb, int qrel, int hi) {
    const int kb = 64 * jb + 4 * hi;
#pragma unroll
    for (int r = 0; r < 16; ++r) { const int kv = kb + (r & 3) + 8 * (r >> 2); if (kv > qrel) p0[r] = -INFINITY; if (kv + 32 > qrel) p1[r] = -INFINITY; }
}
#define MX3(a, b, c) __builtin_fmaxf(__builtin_fmaxf((a), (b)), (c))
__device__ __forceinline__ float rowmax(const f32x16& p0, const f32x16& p1) {
    float a = MX3(p0[0], p0[1], p1[0]), b = MX3(p0[2], p0[3], p1[1]); a = MX3(a, p1[2], p1[3]);
#pragma unroll
    for (int r = 4; r < 16; r += 4) { a = MX3(a, p0[r], p0[r + 1]); b = MX3(b, p0[r + 2], p0[r + 3]); a = MX3(a, p1[r], p1[r + 1]); b = MX3(b, p1[r + 2], p1[r + 3]); }
    float m = __builtin_fmaxf(a, b);
    auto rr = __builtin_amdgcn_permlane32_swap(__float_as_uint(m), __float_as_uint(m), false, false);
    return __builtin_fmaxf(__uint_as_float(rr[0]), __uint_as_float(rr[1]));
}

template <bool DRY>
__device__ __forceinline__ void unit(int b, int h, int qb, const bf16_t* __restrict__ Q, const bf16_t* __restrict__ K, const bf16_t* __restrict__ KPE, const bf16_t* __restrict__ V, bf16_t* G, char* shm, int wid, int& s0, bool pre, bool has_next, int nqb) {
    const int lane = lane_id(), r32 = lane & 31, hi = lane >> 5;
    const long rowbase = (long)b * S; const int q0 = qb * 256;
    const bf16_t* Qw = Q + (rowbase + q0 + wid * 32) * 1536 + h * 96;
    const bf16_t* Kh = K + rowbase * 1024 + h * 64; const bf16_t* Ph = KPE + rowbase * 32; const bf16_t* Vh = V + rowbase * 1024 + h * 64;
    const unsigned lds0 = (unsigned)(uintptr_t)shm;
    float* wsf = (float*)(shm + L_WS) + wid * 64;
    const unsigned koffA = (unsigned)((lane * 1024 + wid * 8) * 2), koffB = (unsigned)((lane * 32 + (wid & 3) * 8) * 2);
    const unsigned voffv = (unsigned)(((16 * (wid & 3) + (lane >> 2)) * 1024 + (wid >> 2) * 32 + (lane & 3) * 8) * 2);
    const unsigned kdstA = lds0 + L_K + wid * 1024, kdstB = lds0 + L_K + (8 + (wid & 3)) * 1024, vdst = lds0 + L_V + wid * 1024;
#define DMA_K(t, sl) do { glds16(Kh + (long)(t) * 64 * 1024, koffA, (unsigned)__builtin_amdgcn_readfirstlane(kdstA + (sl) * KSLOT)); \
                          glds16(Ph + (long)(t) * 64 * 32, koffB, (unsigned)__builtin_amdgcn_readfirstlane(kdstB + (sl) * KSLOT)); } while (0)
#define DMA_V(t, sl) glds16(Vh + (long)(t) * 64 * 1024, voffv, (unsigned)__builtin_amdgcn_readfirstlane(vdst + (sl) * VSLOT))
    const lds_cptr shm3 = (lds_cptr)shm;
    const lds_cptr kp0 = shm3 + L_K + hi * 1024 + r32 * 16;
    const lds_cptr vp0 = shm3 + L_V + ((lane >> 4) & 1) * 32 + (lane & 3) * 8 + (4 * hi + ((lane & 15) >> 2)) * 64;
    const int NT = 4 * (qb + 1);
    const int s1 = (s0 == 2) ? 0 : s0 + 1, s2 = (s1 == 2) ? 0 : s1 + 1;
    if (!pre) { DMA_K(0, s0); DMA_V(0, s0); DMA_K(1, s1); DMA_K(2, s2); }
    const lds_cptr qsp = shm3 + L_QS + wid * 6144 + lane * 16;
    if (!pre) {
        bf16x8 qg[6];
#pragma unroll
        for (int s = 0; s < 6; ++s) qg[s] = *(const bf16x8*)(Qw + (long)r32 * 1536 + s * 16 + hi * 8);
#pragma unroll
        for (int s = 0; s < 6; ++s) *(__attribute__((address_space(3))) bf16x8*)(qsp + s * 1024) = qg[s];
    }
    bf16x8 qr[6];
#pragma unroll
    for (int s = 0; s < 6; ++s) qr[s] = *(const __attribute__((address_space(3))) bf16x8*)(qsp + s * 1024);
    float mhat = 0.f, l_reg = 0.f; f32x16 o[2]; o[0] = f32x16{}; o[1] = f32x16{}; const f32x16 zero16 = f32x16{};
    f32x16 negm = f32x16{};
    const int qrel = wid * 32 + r32;
    bool resc = false;
    bf16x8 kf[12];
#define KLOAD2(sl, j) do { kf[2 * (j)] = *(const __attribute__((address_space(3))) bf16x8*)(kp0 + (sl) * KSLOT + (j) * 2048); \
                           kf[2 * (j) + 1] = *(const __attribute__((address_space(3))) bf16x8*)(kp0 + (sl) * KSLOT + (j) * 2048 + 512); } while (0)
#define RESC() do { if (resc) { asm volatile("s_waitcnt lgkmcnt(0)" ::: "memory"); \
        _Pragma("unroll") for (int d_ = 0; d_ < 2; ++d_) _Pragma("unroll") for (int r = 0; r < 16; ++r) o[d_][r] *= wsf[crow(r, hi)]; } } while (0)
    f32x16 pA0, pA1, pB0, pB1;
    int sl_prev = s0, sl_cur = s0, sl_next = s1;
#define ROT() do { sl_prev = sl_cur; sl_cur = sl_next; sl_next = (sl_next == 2) ? 0 : sl_next + 1; } while (0)
    WAIT_BAR(5);
    { KLOAD2(s0, 0); KLOAD2(s0, 1); KLOAD2(s0, 2); KLOAD2(s0, 3); KLOAD2(s0, 4); KLOAD2(s0, 5);
      pA0 = __builtin_amdgcn_mfma_f32_32x32x16_bf16(kf[0], qr[0], zero16, 0, 0, 0); pA1 = __builtin_amdgcn_mfma_f32_32x32x16_bf16(kf[1], qr[0], zero16, 0, 0, 0);
#pragma unroll
      for (int s = 1; s < 6; ++s) { pA0 = __builtin_amdgcn_mfma_f32_32x32x16_bf16(kf[2 * s], qr[s], pA0, 0, 0, 0); pA1 = __builtin_amdgcn_mfma_f32_32x32x16_bf16(kf[2 * s + 1], qr[s], pA1, 0, 0, 0); }
      if (NT == 4) cmask(pA0, pA1, 0, qrel, hi);
      const float rm = rowmax(pA0, pA1); mhat = rm;
#pragma unroll
      for (int r = 0; r < 16; ++r) { pA0[r] -= rm; pA1[r] -= rm; negm[r] = -rm; }
      asm volatile("" : "+v"(negm));
#pragma unroll
      for (int r = 0; r < 16; ++r) { pA0[r] = __builtin_amdgcn_exp2f(pA0[r]); pA1[r] = __builtin_amdgcn_exp2f(pA1[r]); } }
    WAIT_BAR(0);
    DMA_K(3, s0); DMA_V(1, s1);
    ROT();
    KLOAD2(sl_cur, 0); KLOAD2(sl_cur, 1); KLOAD2(sl_cur, 2); KLOAD2(sl_cur, 3); KLOAD2(sl_cur, 4); KLOAD2(sl_cur, 5);
    WAIT_BAR(3);
    bf16x8 qfa = *(const __attribute__((address_space(3))) bf16x8*)(qsp), qfb;
    s16x4 vlo[8], vhi[8]; u32x4 pw0, pw1, pw2, pw3;
#define PKW(P, B) pk2(P[B], P[(B) + 1])
#define PAF(k) __builtin_bit_cast(bf16x8, pw##k)
#define VFR(i) (bf16x8){vlo[i][0], vlo[i][1], vlo[i][2], vlo[i][3], vhi[i][0], vhi[i][1], vhi[i][2], vhi[i][3]}
#define PIN(x) asm volatile("" : "+v"(x))
#define EX(v) __builtin_amdgcn_exp2f(v)
#define VRD(i) do { vlo[i] = vtr(vp_ + (((i) >> 2) * 4096 + ((i) & 3) * 1024)); vhi[i] = vtr(vp_ + (((i) >> 2) * 4096 + ((i) & 3) * 1024 + 512)); } while (0)
#define QK(Cx, kk, qv, first) Cx = __builtin_amdgcn_mfma_f32_32x32x16_bf16(kf[kk], qv, (first) ? negm : Cx, 0, 0, 0)
#define QLD(dst, s) dst = *(const __attribute__((address_space(3))) bf16x8*)(qsp + (s) * 1024)
#define GAPA3(RD, MF, A0, A1, A2, PK_STMT) do { RD; SBAR(); MF; sacc += A0; sacc += A1; sacc += A2; PIN(sacc); PK_STMT; SBAR(); } while (0)
#define GAPB(KR, MF, X, B) do { KR; MF; X[B] = EX(X[B]); X[(B) + 1] = EX(X[(B) + 1]); X[(B) + 2] = EX(X[(B) + 2]); X[(B) + 3] = EX(X[(B) + 3]); PIN(X); SBAR(); } while (0)
#define STEP(C0, C1, P0, P1, t, GK, GV, GL, BAND) do { SBAR(); \
    const lds_cptr vp_ = vp0 + sl_prev * VSLOT; \
    float sacc = (P0[0] + P0[1]); \
    GAPA3(QLD(qfb, 1), QK(C0, 0, qfa, true),   P0[2],  P0[3],  P0[4],  pw0[0] = PKW(P0, 0); pw0[1] = PKW(P0, 2); PIN(pw0)); \
    GAPA3((void)0, QK(C1, 1, qfa, true),   P0[5],  P0[6],  P0[7],  pw0[2] = PKW(P0, 4); pw0[3] = PKW(P0, 6); PIN(pw0)); \
    GAPA3(QLD(qfa, 2), QK(C0, 2, qfb, false),  P0[8],  P0[9],  P0[10], pw1[0] = PKW(P0, 8); pw1[1] = PKW(P0, 10); PIN(pw1)); \
    GAPA3((void)0, QK(C1, 3, qfb, false),  P0[11], P0[12], P0[13], pw1[2] = PKW(P0, 12); pw1[3] = PKW(P0, 14); PIN(pw1)); \
    GAPA3(QLD(qfb, 3), QK(C0, 4, qfa, false),  P0[14], P0[15], P1[0],  pw2[0] = PKW(P1, 0); PIN(pw2)); \
    GAPA3((void)0, QK(C1, 5, qfa, false),  P1[1],  P1[2],  P1[3],  pw2[1] = PKW(P1, 2); PIN(pw2)); \
    GAPA3(QLD(qfa, 4), QK(C0, 6, qfb, false),  P1[4],  P1[5],  P1[6],  pw2[2] = PKW(P1, 4); PIN(pw2)); \
    GAPA3((void)0, QK(C1, 7, qfb, false),  P1[7],  P1[8],  P1[9],  pw2[3] = PKW(P1, 6); PIN(pw2)); \
    GAPA3({ QLD(qfb, 5); VRD(0); }, QK(C0, 8, qfa, false), P1[10], P1[11], P1[12], pw3[0] = PKW(P1, 8); PIN(pw3)); \
    GAPA3(VRD(1), QK(C1, 9, qfa, false), P1[13], P1[14], P1[15], pw3[1] = PKW(P1, 10); PIN(pw3)); \
    GAPA3(VRD(2), QK(C0, 10, qfb, false), 0.f, 0.f, 0.f,         pw3[2] = PKW(P1, 12); PIN(pw3)); \
    GAPA3(VRD(3), QK(C1, 11, qfb, false), 0.f, 0.f, 0.f,         pw3[3] = PKW(P1, 14); PIN(pw3)); \
    l_reg += sacc; \
    if (GK) { DMA_K((t) + 3, sl_cur); } if (GV) { DMA_V((t) + 1, sl_next); } \
    if (BAND) { const int jb_ = (t) - (NT - 4); if (jb_ >= 0) cmask(C0, C1, jb_, qrel, hi); } \
    { const float rm = rowmax(C0, C1); \
      resc = false; \
      if (__builtin_expect(__any(rm > (float)THRL), 0)) { const float dl = __builtin_fmaxf(rm, 0.f); mhat += dl; \
        _Pragma("unroll") for (int r = 0; r < 16; ++r) { C0[r] -= dl; C1[r] -= dl; } \
        _Pragma("unroll") for (int r = 0; r < 16; ++r) negm[r] = -mhat; asm volatile("" : "+v"(negm)); \
        const float f = __builtin_amdgcn_exp2f(-dl); l_reg *= f; if (hi == 0) wsf[r32] = f; resc = true; } } \
    SBAR(); \
    GAPB({ VRD(4); SBAR(); },                                    o[0] = __builtin_amdgcn_mfma_f32_32x32x16_bf16(PAF(0), VFR(0), o[0], 0, 0, 0), C0, 0); \
    GAPB({ if (GL) { KLOAD2(sl_next, 0); } VRD(5); SBAR(); },     o[0] = __builtin_amdgcn_mfma_f32_32x32x16_bf16(PAF(1), VFR(1), o[0], 0, 0, 0), C0, 4); \
    GAPB({ if (GL) { KLOAD2(sl_next, 1); } VRD(6); SBAR(); },     o[0] = __builtin_amdgcn_mfma_f32_32x32x16_bf16(PAF(2), VFR(2), o[0], 0, 0, 0), C0, 8); \
    GAPB({ if (GL) { KLOAD2(sl_next, 2); } VRD(7); SBAR(); },     o[0] = __builtin_amdgcn_mfma_f32_32x32x16_bf16(PAF(3), VFR(3), o[0], 0, 0, 0), C0, 12); \
    GAPB({ if (GL) { KLOAD2(sl_next, 3); SBAR(); } },             o[1] = __builtin_amdgcn_mfma_f32_32x32x16_bf16(PAF(0), VFR(4), o[1], 0, 0, 0), C1, 0); \
    GAPB({ if (GL) { KLOAD2(sl_next, 4); SBAR(); } },             o[1] = __builtin_amdgcn_mfma_f32_32x32x16_bf16(PAF(1), VFR(5), o[1], 0, 0, 0), C1, 4); \
    GAPB({ if (GL) { KLOAD2(sl_next, 5); SBAR(); } },             o[1] = __builtin_amdgcn_mfma_f32_32x32x16_bf16(PAF(2), VFR(6), o[1], 0, 0, 0), C1, 8); \
    GAPB({ QLD(qfa, 0); SBAR(); },                                 o[1] = __builtin_amdgcn_mfma_f32_32x32x16_bf16(PAF(3), VFR(7), o[1], 0, 0, 0), C1, 12); \
    } while (0)
    int t = 1;
    for (; t + 5 < NT; t += 2) {
        STEP(pB0, pB1, pA0, pA1, t, true, true, true, false);       WAIT_BAR(3); RESC(); ROT();
        STEP(pA0, pA1, pB0, pB1, t + 1, true, true, true, false);   WAIT_BAR(3); RESC(); ROT();
    }
#define ENDW(tt) do { if ((tt) + 3 < NT) { WAIT_BAR(3); } else if ((tt) + 2 < NT) { WAIT_BAR(1); } else { WAIT_BAR(0); } } while (0)
    for (; t + 1 < NT; t += 2) {
        STEP(pB0, pB1, pA0, pA1, t, (t + 3 < NT), (t + 1 < NT), (t + 1 < NT), true);           ENDW(t);     RESC(); ROT();
        STEP(pA0, pA1, pB0, pB1, t + 1, (t + 4 < NT), (t + 2 < NT), (t + 2 < NT), true);       ENDW(t + 1); RESC(); ROT();
    }
    if (has_next) { const int n0 = sl_next, n1 = (n0 == 2) ? 0 : n0 + 1, n2 = (n1 == 2) ? 0 : n1 + 1; DMA_K(0, n0); DMA_V(0, n0); DMA_K(1, n1); DMA_K(2, n2); }
    s0 = sl_next;
    STEP(pB0, pB1, pA0, pA1, NT - 1, false, false, false, true); RESC();
    bf16x8 qn[6];
    if (has_next) { const bf16_t* Qn = Q + (rowbase + nqb * 256 + wid * 32 + r32) * 1536 + h * 96 + hi * 8;
#pragma unroll
        for (int s = 0; s < 6; ++s) qn[s] = *(const bf16x8*)(Qn + s * 16); }
    { float sacc = pB0[0] + pB0[1];
#pragma unroll
      for (int r = 2; r < 16; ++r) sacc += pB0[r];
#pragma unroll
      for (int r = 0; r < 16; ++r) sacc += pB1[r];
      l_reg += sacc;
      pw0 = (u32x4){PKW(pB0, 0), PKW(pB0, 2), PKW(pB0, 4), PKW(pB0, 6)}; pw1 = (u32x4){PKW(pB0, 8), PKW(pB0, 10), PKW(pB0, 12), PKW(pB0, 14)};
      pw2 = (u32x4){PKW(pB1, 0), PKW(pB1, 2), PKW(pB1, 4), PKW(pB1, 6)}; pw3 = (u32x4){PKW(pB1, 8), PKW(pB1, 10), PKW(pB1, 12), PKW(pB1, 14)};
      SBAR();
      const lds_cptr vp_ = vp0 + sl_cur * VSLOT;
#pragma unroll
      for (int d0 = 0; d0 < 2; ++d0) {
#pragma unroll
          for (int i = 0; i < 4; ++i) VRD(4 * d0 + i);
      }
      o[0] = __builtin_amdgcn_mfma_f32_32x32x16_bf16(PAF(0), VFR(0), o[0], 0, 0, 0); o[0] = __builtin_amdgcn_mfma_f32_32x32x16_bf16(PAF(1), VFR(1), o[0], 0, 0, 0);
      o[0] = __builtin_amdgcn_mfma_f32_32x32x16_bf16(PAF(2), VFR(2), o[0], 0, 0, 0); o[0] = __builtin_amdgcn_mfma_f32_32x32x16_bf16(PAF(3), VFR(3), o[0], 0, 0, 0);
      o[1] = __builtin_amdgcn_mfma_f32_32x32x16_bf16(PAF(0), VFR(4), o[1], 0, 0, 0); o[1] = __builtin_amdgcn_mfma_f32_32x32x16_bf16(PAF(1), VFR(5), o[1], 0, 0, 0);
      o[1] = __builtin_amdgcn_mfma_f32_32x32x16_bf16(PAF(2), VFR(6), o[1], 0, 0, 0); o[1] = __builtin_amdgcn_mfma_f32_32x32x16_bf16(PAF(3), VFR(7), o[1], 0, 0, 0); }
    bf16_t* Gw = G + (rowbase + q0 + wid * 32) * 1024 + h * 64;
    u32x4 gvv[4];
#pragma unroll
    for (int i = 0; i < 4; ++i) gvv[i] = *(const u32x4*)(Gw + (long)(i * 8 + (lane >> 3)) * 1024 + (lane & 7) * 8);
    { auto rr = __builtin_amdgcn_permlane32_swap(__float_as_uint(l_reg), __float_as_uint(l_reg), false, false); l_reg = __uint_as_float(rr[0]) + __uint_as_float(rr[1]); }
    if (hi == 0) wsf[32 + r32] = l_reg;
    asm volatile("s_waitcnt lgkmcnt(0)" ::: "memory");
    { bf16_t* stg = (bf16_t*)(shm + L_OST) + wid * 2048;
#pragma unroll
      for (int r = 0; r < 16; ++r) { const int orow = crow(r, hi); const float rl = __builtin_amdgcn_rcpf(wsf[32 + orow]);
          stg[orow * 64 + r32] = (bf16_t)(pk2(o[0][r] * rl, 0.f) & 0xffffu); stg[orow * 64 + 32 + r32] = (bf16_t)(pk2(o[1][r] * rl, 0.f) & 0xffffu); }
      asm volatile("s_waitcnt lgkmcnt(0)" ::: "memory");
#pragma unroll
      for (int i = 0; i < 4; ++i) { const int row = i * 8 + (lane >> 3), ch = lane & 7;
          const u32x4 ov = *(const u32x4*)(stg + row * 64 + ch * 8);
          bf16_t* gp = Gw + (long)row * 1024 + ch * 8;
          const u32x4 gv = gvv[i]; u32x4 w;
#pragma unroll
          for (int e = 0; e < 4; ++e) w[e] = pk2(bflo(ov[e]) * bflo(gv[e]), bfhi(ov[e]) * bfhi(gv[e]));
          if (DRY) asm volatile("" :: "v"(w)); else *(u32x4*)gp = w; } }
    if (has_next) {
#pragma unroll
        for (int s = 0; s < 6; ++s) *(__attribute__((address_space(3))) bf16x8*)(qsp + s * 1024) = qn[s];
    }
    asm volatile("s_waitcnt lgkmcnt(0)\n\ts_barrier" ::: "memory");
#undef DMA_K
#undef DMA_V
#undef KLOAD2
#undef RESC
#undef ROT
#undef PKW
#undef PAF
#undef VFR
#undef PIN
#undef EX
#undef VRD
#undef QK
#undef QLD
#undef GAPA3
#undef GAPB
#undef STEP
#undef ENDW
}
#undef SBAR
#undef WAIT_BAR
#undef MX3
template <bool DRY>
__device__ __forceinline__ void phase(char* lds, const bf16_t* Q, const bf16_t* K, const bf16_t* KPE, const bf16_t* V, bf16_t* G, int vcu, int ncu, int wid) {
    for (int v = vcu; v < 256; v += ncu) {
        const int bh = v >> 2, s = v & 3;
        int s0 = 0;
#pragma unroll 1
        for (int i = 0; i < 4; ++i) { const int qb = (i == 0) ? s : (i == 1) ? 7 - s : (i == 2) ? 8 + s : 15 - s; const int nqb = (i == 0) ? 7 - s : (i == 1) ? 8 + s : 15 - s;
            const long bq = bh >> 4;
            unit<DRY>(bh >> 4, bh & 15, qb, Q + bq * D_Q, K + bq * D_KV, KPE + bq * D_KPE, V + bq * D_KV, G, lds, wid, s0, i > 0, i < 3, nqb); }
        asm volatile("s_waitcnt vmcnt(0)" ::: "memory");
    }
}
}

namespace band {
constexpr int LW = 18176;
__device__ __forceinline__ int crow(int r, int hi) { return (r & 3) + 8 * (r >> 2) + 4 * hi; }
template <int OFF> __device__ __forceinline__ s16x4 tr_read(int vb) {
    s16x4 r; asm volatile("ds_read_b64_tr_b16 %0, %1 offset:%2" : "=&v"(r) : "v"(vb), "i"(OFF) : "memory"); return r;
}
struct BandPre { float tv[3]; bf16x8 qf[4]; bf16x8 k0[4]; };
__device__ __forceinline__ void item_prefetch(BandPre& P, const bf16_t* __restrict__ QKV, int b, int qcol, int kcol, int vcol, int dil, int res, int i0, const float* __restrict__ tabg) {
    const int lane = lane_id(), r32 = lane & 31, hi = lane >> 5;
    const long rowpitch = (long)dil * QKV_W;
    const bf16_t* base = QKV + ((long)b * S + res) * QKV_W;
#pragma unroll
    for (int i = 0; i < 3; ++i) { const int j = 190 - (lane + 64 * i); P.tv[i] = (j >= 0) ? tabg[j] : -INFINITY; }
    { const bf16_t* qp = base + (long)(i0 + r32) * rowpitch + qcol + 8 * hi;
#pragma unroll
      for (int s = 0; s < 4; ++s) P.qf[s] = *(const bf16x8*)(qp + 16 * s); }
    const int jk = (i0 >= 128) ? (i0 - 128) : i0;
    const char* sb = (const char*)base + (long)jk * rowpitch * 2 + (long)(kcol - vcol) * 2;
#pragma unroll
    for (int i = 0; i < 4; ++i) P.k0[i] = *(const bf16x8*)(sb + (unsigned)(((8 * i + (lane >> 3)) * (int)rowpitch + vcol + (lane & 7) * 8) * 2));
}
template <int MODE, bool DRY>
__device__ __forceinline__ void item(BandPre& P, const bf16_t* __restrict__ QKV, int b, int qcol, int kcol, int vcol, int dil, int res, int i0, float sink2,
                                     bf16_t* outp, long out_pitch, float* lsep, int lse_pitch, LAS unsigned char* wl,
                                     bool has_next, int n_b, int n_qcol, int n_kcol, int n_vcol, int n_dil, int n_res, int n_i0, const float* __restrict__ n_tabg) {
    const int lane = lane_id();
    const int r32 = lane & 31, hi = lane >> 5;
    const long rowpitch = (long)dil * QKV_W;
    const bf16_t* base = QKV + ((long)b * S + res) * QKV_W;
    LAS unsigned char* kl = wl + 8192;
    LAS float* tab = (LAS float*)(wl + 16384);
    LAS float* scr = (LAS float*)(wl + 16384 + 1536);
    float tv[3]; bf16x8 qf[4];
#pragma unroll
    for (int i = 0; i < 3; ++i) tv[i] = P.tv[i];
#pragma unroll
    for (int s = 0; s < 4; ++s) qf[s] = P.qf[s];
    const int kmin = (i0 >= 128) ? 0 : 4 - (i0 >> 5);
    bf16x8 kr[5][4], vr[5][4];
#pragma unroll
    for (int i = 0; i < 4; ++i) kr[0][i] = P.k0[i];
    unsigned voff[4];
#pragma unroll
    for (int i = 0; i < 4; ++i) voff[i] = (unsigned)(((8 * i + (lane >> 3)) * (int)rowpitch + vcol + (lane & 7) * 8) * 2);
    const long kdelta = (long)(kcol - vcol) * 2;
#pragma unroll
    for (int k = 1; k < 5; ++k) {
        const int jk = (k >= kmin) ? (i0 - 128 + 32 * k) : i0;
        const char* sb = (const char*)base + (long)jk * rowpitch * 2;
#pragma unroll
        for (int i = 0; i < 4; ++i) kr[k][i] = *(const bf16x8*)(sb + kdelta + voff[i]);
    }
#pragma unroll
    for (int k = 0; k < 5; ++k) {
        const int jk = (k >= kmin) ? (i0 - 128 + 32 * k) : i0;
        const char* sb = (const char*)base + (long)jk * rowpitch * 2;
#pragma unroll
        for (int i = 0; i < 4; ++i) vr[k][i] = *(const bf16x8*)(sb + voff[i]);
    }
    const int vst = ((lane & 7) >> 2) * 2048 + (lane >> 3) * 64 + (lane & 3) * 16;
    const int vb = (int)(uintptr_t)wl + (4 * hi + ((lane & 15) >> 2)) * 64 + ((lane >> 4) & 1) * 32 + (lane & 3) * 8;
    const int kst = (lane >> 3) * 128 + (((lane & 7) ^ ((lane >> 3) & 7)) << 4);
#pragma unroll
    for (int i = 0; i < 3; ++i) { tab[lane + 64 * i] = tv[i]; tab[192 + lane + 64 * i] = -INFINITY; }
    f32x16 p[5];
#pragma unroll
    for (int k = 0; k < 5; ++k) {
        LAS unsigned char* kb = kl + (k & 1) * 4096;
#pragma unroll
        for (int i = 0; i < 4; ++i) *(LAS bf16x8*)(kb + kst + i * 1024) = kr[k][i];
        const LAS float* tk = tab + ((k >= kmin) ? 0 : 192) + (31 - r32 + 32 * k);
        f32x16 acc;
#pragma unroll
        for (int r = 0; r < 16; ++r) acc[r] = tk[crow(r, hi)];
        bf16x8 ka[4];
#pragma unroll
        for (int s2 = 0; s2 < 4; ++s2) ka[s2] = *(const LAS bf16x8*)(kb + r32 * 128 + (((2 * s2 + hi) ^ (r32 & 7)) << 4));
        asm volatile("s_waitcnt lgkmcnt(0)" : "+v"(acc), "+v"(ka[0]), "+v"(ka[1]), "+v"(ka[2]), "+v"(ka[3]) :: "memory");
#pragma unroll
        for (int s2 = 0; s2 < 4; ++s2) acc = __builtin_amdgcn_mfma_f32_32x32x16_bf16(ka[s2], qf[s2], acc, 0, 0, 0);
        p[k] = acc;
    }
    u32x4 gv[4];
    if (MODE == 0) {
#pragma unroll
        for (int i = 0; i < 4; ++i) gv[i] = *(const u32x4*)(outp + (long)(i * 8 + (lane >> 3)) * out_pitch + (lane & 7) * 8);
    }
    float m = p[0][0];
#pragma unroll
    for (int k = 0; k < 5; ++k)
#pragma unroll
        for (int r = 0; r < 16; ++r) m = fmaxf(m, p[k][r]);
    { auto rr = __builtin_amdgcn_permlane32_swap(__float_as_uint(m), __float_as_uint(m), false, false); m = fmaxf(__uint_as_float(rr[0]), __uint_as_float(rr[1])); }
    if (MODE == 0) m = fmaxf(m, sink2);
    float l = 0.f;
#pragma unroll
    for (int k = 0; k < 5; ++k)
#pragma unroll
        for (int r = 0; r < 16; ++r) { p[k][r] = __builtin_amdgcn_exp2f(p[k][r] - m); l += p[k][r]; }
    { auto rr = __builtin_amdgcn_permlane32_swap(__float_as_uint(l), __float_as_uint(l), false, false); l = __uint_as_float(rr[0]) + __uint_as_float(rr[1]); }
    if (MODE == 0) l += __builtin_amdgcn_exp2f(sink2 - m);
    bf16x8 pa[5][2];
#pragma unroll
    for (int k = 0; k < 5; ++k) {
        u32x4 w;
        w.x = pk2(p[k][0], p[k][1]); w.y = pk2(p[k][2], p[k][3]); w.z = pk2(p[k][4], p[k][5]); w.w = pk2(p[k][6], p[k][7]); pa[k][0] = __builtin_bit_cast(bf16x8, w);
        w.x = pk2(p[k][8], p[k][9]); w.y = pk2(p[k][10], p[k][11]); w.z = pk2(p[k][12], p[k][13]); w.w = pk2(p[k][14], p[k][15]); pa[k][1] = __builtin_bit_cast(bf16x8, w);
    }
    if (has_next) item_prefetch(P, QKV, n_b, n_qcol, n_kcol, n_vcol, n_dil, n_res, n_i0, n_tabg);
    f32x16 o[2]; o[0] = f32x16{}; o[1] = f32x16{};
#pragma unroll
    for (int k = 0; k < 5; ++k) {
        const bf16x8 pa0 = pa[k][0], pa1 = pa[k][1];
        LAS unsigned char* vbuf = wl + (k & 1) * 4096;
#pragma unroll
        for (int i = 0; i < 4; ++i) *(LAS bf16x8*)(vbuf + vst + i * 512) = vr[k][i];
        asm volatile("s_waitcnt lgkmcnt(0)" ::: "memory");
        const int vbk = vb + (k & 1) * 4096;
        const s16x4 a0 = tr_read<0>(vbk), a1 = tr_read<512>(vbk), a2 = tr_read<1024>(vbk), a3 = tr_read<1536>(vbk);
        const s16x4 c0 = tr_read<2048>(vbk), c1 = tr_read<2048 + 512>(vbk), c2 = tr_read<2048 + 1024>(vbk), c3 = tr_read<2048 + 1536>(vbk);
        asm volatile("s_waitcnt lgkmcnt(0)" ::: "memory"); __builtin_amdgcn_sched_barrier(0);
#define PKV(L, H) (bf16x8){L[0], L[1], L[2], L[3], H[0], H[1], H[2], H[3]}
        o[0] = __builtin_amdgcn_mfma_f32_32x32x16_bf16(PKV(a0, a1), pa0, o[0], 0, 0, 0);
        o[0] = __builtin_amdgcn_mfma_f32_32x32x16_bf16(PKV(a2, a3), pa1, o[0], 0, 0, 0);
        o[1] = __builtin_amdgcn_mfma_f32_32x32x16_bf16(PKV(c0, c1), pa0, o[1], 0, 0, 0);
        o[1] = __builtin_amdgcn_mfma_f32_32x32x16_bf16(PKV(c2, c3), pa1, o[1], 0, 0, 0);
#undef PKV
    }
    const float rl = __builtin_amdgcn_rcpf(l);
    LAS unsigned char* stg = wl;
#pragma unroll
    for (int d0 = 0; d0 < 2; ++d0)
#pragma unroll
        for (int g = 0; g < 4; ++g) {
            u32x2 w; w.x = pk2(o[d0][4 * g] * rl, o[d0][4 * g + 1] * rl); w.y = pk2(o[d0][4 * g + 2] * rl, o[d0][4 * g + 3] * rl);
            *(LAS u32x2*)(stg + r32 * 144 + (32 * d0 + 8 * g + 4 * hi) * 2) = w;
        }
    asm volatile("s_waitcnt lgkmcnt(0)" ::: "memory");
#pragma unroll
    for (int i = 0; i < 4; ++i) {
        const int row = i * 8 + (lane >> 3), ch = lane & 7;
        const u32x4 ov = *(const LAS u32x4*)(stg + row * 144 + ch * 16);
        bf16_t* gp = outp + (long)row * out_pitch + ch * 8;
        if (MODE == 0) {
            u32x4 w;
#pragma unroll
            for (int e = 0; e < 4; ++e) w[e] = pk2(bflo(ov[e]) * bflo(gv[i][e]), bfhi(ov[e]) * bfhi(gv[i][e]));
            if (DRY) asm volatile("" :: "v"(w)); else *(u32x4*)gp = w;
        } else { if (DRY) asm volatile("" :: "v"(ov)); else *(u32x4*)gp = ov; }
    }
    if (MODE == 1 && !DRY) { if (hi == 0) lsep[(long)r32 * lse_pitch] = m + __builtin_amdgcn_logf(l); }
    asm volatile("s_waitcnt lgkmcnt(0)" ::: "memory");
}

template <bool DRY>
__device__ __forceinline__ void phase(LAS unsigned char* lds, const bf16_t* QKV0, bf16_t* G, bf16_t* OC0, float* LSE0, const float* BT, const float* sinks, int vcu, int ncu, int wave, int lane) {
    LAS unsigned char* wl = lds + wave * LW;
    for (int u = vcu; u < 256; u += ncu) {
        const int b = u >> 6, h = (u >> 3) & 7, t0 = (u & 7) * 512;
        const bf16_t* QKV = QKV0 + (long)b * D_QKV; bf16_t* OC = OC0 + (long)b * D_OC; float* LSE = LSE0 + (long)b * D_LSE;
#define B_ITEM_PARAMS(it_, dil_, res_, i0_, cfg_) const int cfg_ = (it_) >> 4, w_##cfg_ = (it_) & 15; const int dil_ = (cfg_ == 0) ? 1 : (cfg_ == 1) ? 4 : 16; \
            const int res_ = (cfg_ == 0) ? 0 : (cfg_ == 1) ? (w_##cfg_ & 3) : w_##cfg_; const int i0_ = t0 / dil_ + 32 * ((cfg_ == 0) ? w_##cfg_ : (cfg_ == 1) ? (w_##cfg_ >> 2) : 0)
        BandPre P;
        { B_ITEM_PARAMS(wave, dil, res, i0, cfg); item_prefetch(P, QKV, b, 768 + h * 64, 1280 + h * 64, 1792 + h * 64, dil, res, i0, BT + ((1 + cfg) * 8 + h) * 192); }
#define A_ITEM_PARAMS(ia_, g32_, ha_, ba_) const int id_##g32_ = u * 16 + (ia_), g32_ = id_##g32_ & 127, ha_ = (id_##g32_ >> 7) & 7, ba_ = id_##g32_ >> 10
#pragma unroll 1
        for (int it = wave; it < 48; it += 8) {
            B_ITEM_PARAMS(it, dil, res, i0, cfg);
            const bool nb_ = (it + 8 < 48);
            const int itn = nb_ ? it + 8 : it;
            B_ITEM_PARAMS(itn, ndil, nres, ni0, ncfg);
            A_ITEM_PARAMS(wave, ag32, aha, aba);
            const long tok0 = (long)b * S + res + (long)dil * i0;
            item<1, false>(P, QKV, b, 768 + h * 64, 1280 + h * 64, 1792 + h * 64, dil, res, i0, 0.f,
                    OC + (size_t)cfg * S * 512 + tok0 * 512 + h * 64, (long)dil * 512, LSE + (size_t)cfg * S * 8 + tok0 * 8 + h, dil * 8, wl,
                    true, nb_ ? b : aba, nb_ ? 768 + h * 64 : aha * 64, nb_ ? 1280 + h * 64 : 512 + (aha >> 2) * 64, nb_ ? 1792 + h * 64 : 640 + (aha >> 2) * 64,
                    nb_ ? ndil : 1, nb_ ? nres : 0, nb_ ? ni0 : ag32 * 32, nb_ ? BT + ((1 + ncfg) * 8 + h) * 192 : BT + aha * 192);
        }
#pragma unroll 1
        for (int ia = wave; ia < 16; ia += 8) {
            A_ITEM_PARAMS(ia, g32, ha, ba);
            const int ian = (ia + 8 < 16) ? ia + 8 : ia;
            A_ITEM_PARAMS(ian, ng32, nha, nba);
            const int kvh = ha >> 2, i0 = g32 * 32;
            item<0, DRY>(P, QKV, ba, ha * 64, 512 + kvh * 64, 640 + kvh * 64, 1, 0, i0, sinks[ha] * LOG2E,
                    G + ((long)ba * S + i0) * 1024 + ha * 64, 1024, nullptr, 0, wl,
                    ia + 8 < 16, nba, nha * 64, 512 + (nha >> 2) * 64, 640 + (nha >> 2) * 64, 1, 0, ng32 * 32, BT + nha * 192);
        }
        asm volatile("s_waitcnt vmcnt(0)" ::: "memory");
        __syncthreads();
        {
            const int tid = wave * 64 + lane_id();
#pragma unroll 1
            for (int i0 = 0; i0 < 8; i0 += 4) {
                float lse_[4][3]; u32x4 oc_[4][3], gv_[4];
#pragma unroll
                for (int j = 0; j < 4; ++j) {
                    const int e = tid + 512 * (i0 + j), tau = e >> 3, ch = e & 7;
                    const long tok = (long)b * S + t0 + tau;
#pragma unroll
                    for (int c = 0; c < 3; ++c) { lse_[j][c] = LSE[(size_t)c * S * 8 + tok * 8 + h]; oc_[j][c] = *(const u32x4*)(OC + (size_t)c * S * 512 + tok * 512 + h * 64 + ch * 8); }
                    gv_[j] = *(const u32x4*)(G + tok * 1024 + 512 + h * 64 + ch * 8);
                }
                asm volatile("" ::: "memory");
#pragma unroll
                for (int j = 0; j < 4; ++j) {
                    const int e = tid + 512 * (i0 + j), tau = e >> 3, ch = e & 7;
                    const long tok = (long)b * S + t0 + tau;
                    const float mx = fmaxf(lse_[j][0], fmaxf(lse_[j][1], lse_[j][2]));
                    float w0 = __builtin_amdgcn_exp2f(lse_[j][0] - mx), w1 = __builtin_amdgcn_exp2f(lse_[j][1] - mx), w2 = __builtin_amdgcn_exp2f(lse_[j][2] - mx);
                    const float rs = 1.f / (w0 + w1 + w2); w0 *= rs; w1 *= rs; w2 *= rs;
                    u32x4 wv;
#pragma unroll
                    for (int q = 0; q < 4; ++q) {
                        const float lo = w0 * bflo(oc_[j][0][q]) + w1 * bflo(oc_[j][1][q]) + w2 * bflo(oc_[j][2][q]), hv = w0 * bfhi(oc_[j][0][q]) + w1 * bfhi(oc_[j][1][q]) + w2 * bfhi(oc_[j][2][q]);
                        wv[q] = pk2(lo * bflo(gv_[j][q]), hv * bfhi(gv_[j][q]));
                    }
                    bf16_t* gp = G + tok * 1024 + 512 + h * 64 + ch * 8;
                    if (DRY) asm volatile("" :: "v"(wv)); else *(u32x4*)gp = wv;
                }
            }
        }
        __syncthreads();
    }
}
}

__global__ __launch_bounds__(256) void naive_ab_attn(const bf16_t* __restrict__ QKV, bf16_t* G, const float* __restrict__ BT, const float* __restrict__ sinks) {
    for (long idx = (long)blockIdx.x * 256 + threadIdx.x; idx < (long)T * 16; idx += (long)gridDim.x * 256) {
        const int hh = (int)(idx / T), t = (int)(idx % T), b = t / S, s = t % S;
        int qoff, koff, voff, ncfg, cfg0, h;
        if (hh < 8) { h = hh; qoff = h * 64; koff = 512 + (h >> 2) * 64; voff = 640 + (h >> 2) * 64; ncfg = 1; cfg0 = 0; }
        else { h = hh - 8; qoff = 768 + h * 64; koff = 1280 + h * 64; voff = 1792 + h * 64; ncfg = 3; cfg0 = 1; }
        bf16x8 q[8];
#pragma unroll
        for (int i = 0; i < 8; ++i) q[i] = *(const bf16x8*)(QKV + (size_t)t * QKV_W + qoff + 8 * i);
        float mx = (hh < 8) ? sinks[h] * LOG2E : -INFINITY;
        for (int c = 0; c < ncfg; ++c) {
            const int dil = (c == 0) ? 1 : ((c == 1) ? 4 : 16);
            const float* bt = BT + ((cfg0 + c) * 8 + h) * 192 + 31;
            for (int dl = 0; dl <= 128; ++dl) {
                const int j = s - dil * dl; if (j < 0) break;
                const bf16_t* kr = QKV + (size_t)(b * S + j) * QKV_W + koff;
                float sc = 0.f;
#pragma unroll
                for (int i = 0; i < 8; ++i) sc = dot8(q[i], *(const bf16x8*)(kr + 8 * i), sc);
                mx = fmaxf(mx, sc + bt[dl]);
            }
        }
        float l = (hh < 8) ? exp2f(sinks[h] * LOG2E - mx) : 0.f;
        float o[64];
#pragma unroll
        for (int d = 0; d < 64; ++d) o[d] = 0.f;
        for (int c = 0; c < ncfg; ++c) {
            const int dil = (c == 0) ? 1 : ((c == 1) ? 4 : 16);
            const float* bt = BT + ((cfg0 + c) * 8 + h) * 192 + 31;
            for (int dl = 0; dl <= 128; ++dl) {
                const int j = s - dil * dl; if (j < 0) break;
                const bf16_t* kr = QKV + (size_t)(b * S + j) * QKV_W + koff;
                const bf16_t* vr = QKV + (size_t)(b * S + j) * QKV_W + voff;
                float sc = 0.f;
#pragma unroll
                for (int i = 0; i < 8; ++i) sc = dot8(q[i], *(const bf16x8*)(kr + 8 * i), sc);
                const float p = exp2f(sc + bt[dl] - mx);
                l += p;
#pragma unroll
                for (int i = 0; i < 8; ++i) {
                    const u32x4 vv = __builtin_bit_cast(u32x4, *(const bf16x8*)(vr + 8 * i));
#pragma unroll
                    for (int e = 0; e < 4; ++e) { o[8 * i + 2 * e] = fmaf(p, bflo(vv[e]), o[8 * i + 2 * e]); o[8 * i + 2 * e + 1] = fmaf(p, bfhi(vv[e]), o[8 * i + 2 * e + 1]); }
                }
            }
        }
        const float rl = 1.f / l;
        bf16_t* gp = G + (size_t)t * DM + hh * 64;
#pragma unroll
        for (int i = 0; i < 8; ++i) {
            const u32x4 gv = *(const u32x4*)(gp + 8 * i); u32x4 w;
#pragma unroll
            for (int e = 0; e < 4; ++e) w[e] = pk2(o[8 * i + 2 * e] * rl * bflo(gv[e]), o[8 * i + 2 * e + 1] * rl * bfhi(gv[e]));
            *(u32x4*)(gp + 8 * i) = w;
        }
    }
}

__global__ __launch_bounds__(256) void naive_mla_attn(const bf16_t* __restrict__ Q, const bf16_t* __restrict__ K, const bf16_t* __restrict__ KPE, const bf16_t* __restrict__ V, bf16_t* G) {
    for (long idx = (long)blockIdx.x * 256 + threadIdx.x; idx < (long)T * 16; idx += (long)gridDim.x * 256) {
        const int h = (int)(idx / T), t = (int)(idx % T), b = t / S, s = t % S;
        bf16x8 q[12];
#pragma unroll
        for (int i = 0; i < 12; ++i) q[i] = *(const bf16x8*)(Q + (size_t)t * 1536 + h * 96 + 8 * i);
        float mx = -INFINITY, l = 0.f;
        float o[64];
#pragma unroll
        for (int d = 0; d < 64; ++d) o[d] = 0.f;
        for (int j = 0; j <= s; ++j) {
            const bf16_t* kr = K + (size_t)(b * S + j) * 1024 + h * 64;
            const bf16_t* pr = KPE + (size_t)(b * S + j) * 32;
            const bf16_t* vr = V + (size_t)(b * S + j) * 1024 + h * 64;
            float sc = 0.f;
#pragma unroll
            for (int i = 0; i < 8; ++i) sc = dot8(q[i], *(const bf16x8*)(kr + 8 * i), sc);
#pragma unroll
            for (int i = 0; i < 4; ++i) sc = dot8(q[8 + i], *(const bf16x8*)(pr + 8 * i), sc);
            if (sc > mx) {
                const float f = exp2f(mx - sc); l *= f;
#pragma unroll
                for (int d = 0; d < 64; ++d) o[d] *= f;
                mx = sc;
            }
            const float p = exp2f(sc - mx);
            l += p;
#pragma unroll
            for (int i = 0; i < 8; ++i) {
                const u32x4 vv = __builtin_bit_cast(u32x4, *(const bf16x8*)(vr + 8 * i));
#pragma unroll
                for (int e = 0; e < 4; ++e) { o[8 * i + 2 * e] = fmaf(p, bflo(vv[e]), o[8 * i + 2 * e]); o[8 * i + 2 * e + 1] = fmaf(p, bfhi(vv[e]), o[8 * i + 2 * e + 1]); }
            }
        }
        const float rl = 1.f / l;
        bf16_t* gp = G + (size_t)t * DM + h * 64;
#pragma unroll
        for (int i = 0; i < 8; ++i) {
            const u32x4 gv = *(const u32x4*)(gp + 8 * i); u32x4 w;
#pragma unroll
            for (int e = 0; e < 4; ++e) w[e] = pk2(o[8 * i + 2 * e] * rl * bflo(gv[e]), o[8 * i + 2 * e + 1] * rl * bfhi(gv[e]));
            *(u32x4*)(gp + 8 * i) = w;
        }
    }
}

#define XB_TMO      128
#define XB_XCNT(j)  (256  + 64 * (j))
#define XB_XSUB(j)  (1280 + 64 * (j))
#define XB_XGEN(j)  (2304 + 64 * (j))
#define XB_TOP      3328
#define XB_TOPGEN   3392
#define XCD_BAR_WORDS 3456
#define XB_SPIN_CAP (1u << 20)
__device__ __forceinline__ unsigned xb_ld(unsigned* p)              { return __hip_atomic_load(p, __ATOMIC_RELAXED, __HIP_MEMORY_SCOPE_AGENT); }
__device__ __forceinline__ unsigned xb_add(unsigned* p, unsigned v) { return __hip_atomic_fetch_add(p, v, __ATOMIC_RELAXED, __HIP_MEMORY_SCOPE_AGENT); }
__device__ __forceinline__ unsigned xb_xcc_id() { return (unsigned)__builtin_amdgcn_s_getreg((3 << 11) | 20) & 0xFu; }
#define XB_SPIN(cond, bar) do { unsigned _sp = 0; while (cond) { __builtin_amdgcn_s_sleep(1); \
    if ((++_sp & 255u) == 0u) { if (xb_ld(&(bar)[XB_TMO])) break; if (_sp > XB_SPIN_CAP) { atomicAdd(&(bar)[XB_TMO], 1u); break; } } } } while (0)
__device__ __forceinline__ void xcd_barrier_complete(unsigned* bar, unsigned x, unsigned G, unsigned& nloc, unsigned& nx) {
    unsigned sum, cnt, mine, sp = 0u;
    for (;;) {
        sum = 0u; cnt = 0u; mine = 0u;
#pragma unroll
        for (unsigned j = 0; j < 16; ++j) { const unsigned c = xb_ld(&bar[XB_XCNT(j)]); sum += c; cnt += (c > 0u) ? 1u : 0u; mine = (j == x) ? c : mine; }
        if (sum == G) break;
        __builtin_amdgcn_s_sleep(1);
        if ((++sp & 255u) == 0u) { if (xb_ld(&bar[XB_TMO])) break; if (sp > XB_SPIN_CAP) { atomicAdd(&bar[XB_TMO], 1u); break; } }
    }
    nloc = mine > 0u ? mine : 1u; nx = cnt > 0u ? cnt : 1u;
}
__device__ __forceinline__ void xcd_barrier(unsigned* bar, unsigned x, volatile LAS unsigned* st, unsigned G, int wave) {
    asm volatile("s_waitcnt vmcnt(0)" ::: "memory");
    __syncthreads();
    if (wave == 0) { if (lane_id() == 0) {
        __builtin_amdgcn_s_waitcnt(0);
        unsigned nloc = st[0], nx = st[1];
        if (nloc == 0u) { xcd_barrier_complete(bar, x, G, nloc, nx); st[0] = nloc; st[1] = nx; }
        asm volatile("buffer_inv sc1" ::: "memory");
        const unsigned old = xb_add(&bar[XB_XSUB(x)], 1u);
        const unsigned gen = old / nloc;
        if (old + 1u == (gen + 1u) * nloc) {
            __builtin_amdgcn_fence(__ATOMIC_RELEASE, "agent");
            asm volatile("s_waitcnt vmcnt(0)" ::: "memory");
            (void)xb_add(&bar[XB_TOP], 1u);
            XB_SPIN(xb_ld(&bar[XB_TOP]) < (gen + 1u) * nx, bar);
            (void)xb_add(&bar[XB_TOPGEN], 1u);
            xb_add(&bar[XB_XGEN(x)], 1u);
            asm volatile("s_waitcnt vmcnt(0)" ::: "memory");
        } else {
            XB_SPIN(xb_ld(&bar[XB_XGEN(x)]) == gen, bar);
            asm volatile("s_waitcnt vmcnt(0)" ::: "memory");
        }
    } }
    __syncthreads();
}

__device__ __forceinline__ void octet_barrier(unsigned* ctr, unsigned* bar, volatile LAS unsigned* st, int wave) {
    asm volatile("s_waitcnt vmcnt(0)" ::: "memory");
    __syncthreads();
    if (wave == 0) { if (lane_id() == 0) {
        __builtin_amdgcn_s_waitcnt(0);
        const unsigned n = st[3], target = (n + 1u) * 32u;
        asm volatile("buffer_inv sc1" ::: "memory");
        (void)xb_add(ctr, 1u);
        XB_SPIN(xb_ld(ctr) < target, bar);
        asm volatile("s_waitcnt vmcnt(0)" ::: "memory");
        st[3] = n + 1u;
    } }
    __syncthreads();
}

constexpr int N_PHASES = 16;
constexpr int LDS_BYTES = 147456;
enum PhaseKind { PK_PRO = 0, PK_ABIN, PK_ABATT, PK_OUT, PK_CIN, PK_CQKV, PK_CATT, PK_FIN };
__host__ __device__ constexpr int phase_kind(int p) {
    return p == 0 ? PK_PRO : p == 15 ? PK_FIN : (p == 1 || p == 8) ? PK_ABIN : (p == 2 || p == 9) ? PK_ABATT : (p == 3 || p == 10 || p == 7 || p == 14) ? PK_OUT
         : (p == 4 || p == 11) ? PK_CIN : (p == 5 || p == 12) ? PK_CQKV : PK_CATT;
}
__host__ __device__ constexpr int phase_layer(int p) { return p <= 3 ? 0 : p <= 7 ? 1 : p <= 10 ? 2 : 3; }

__host__ __device__ inline Gemm make_gemm(const Args& a, int p, int which) {
    unsigned char* ws = a.ws; const int kind = phase_kind(p), layer = phase_layer(p), li = layer >> 1;
    const bf16_t* XB = (const bf16_t*)(ws + WS_XB); const bf16_t* Gb = (const bf16_t*)(ws + WS_G);
    if (kind == PK_ABIN) return Gemm{XB, (const bf16_t*)(ws + W_ABIN) + (size_t)li * AB_IN * DM, T, AB_IN, DM, 0};
    if (kind == PK_OUT) return Gemm{Gb, (const bf16_t*)(ws + ((layer & 1) ? W_COUT : W_ABOUT)) + (size_t)li * DM * DM, T, DM, DM, 0};
    if (kind == PK_CIN) return Gemm{XB, (const bf16_t*)(ws + W_CIN) + (size_t)li * C_INP * DM, T, C_INP, DM, 0};
    if (which == 0) return Gemm{(const bf16_t*)(ws + WS_CQ), (const bf16_t*)(ws + W_CQB) + (size_t)li * 1536 * 256, T, 1536, 256, (int)(D_CQ * 2)};
    return Gemm{(const bf16_t*)(ws + WS_CKV), (const bf16_t*)(ws + W_CKVB) + (size_t)li * 2048 * 128, T, 2048, 128, (int)(D_CKV * 2)};
}
__host__ __device__ inline EpiABin make_epi_abin(const Args& a) { return EpiABin{(bf16_t*)(a.ws + WS_QKV), (bf16_t*)(a.ws + WS_G), (const float*)(a.ws + WS_SSQ)}; }
__host__ __device__ inline EpiOut make_epi_out(const Args& a, int p) { (void)p; return EpiOut{(bf16_t*)(a.ws + WS_XB), (unsigned char*)a.out, (float*)(a.ws + WS_SSQ)}; }
__host__ __device__ inline EpiCin make_epi_cin(const Args& a) {
    return EpiCin{(bf16_t*)(a.ws + WS_CQ), (bf16_t*)(a.ws + WS_CKV), (bf16_t*)(a.ws + WS_KPE), (bf16_t*)(a.ws + WS_G), (const float*)(a.ws + WS_SSQ),
                  (float*)(a.ws + WS_SSQQ), (float*)(a.ws + WS_SSQKV), (const float*)(a.ws + WS_ROPE), 0, 0}; }
__host__ __device__ inline EpiQ make_epi_q(const Args& a) { return EpiQ{(bf16_t*)(a.ws + WS_Q), (const float*)(a.ws + WS_SSQQ), (const float*)(a.ws + WS_ROPE)}; }
__host__ __device__ inline EpiKV make_epi_kv(const Args& a) { return EpiKV{(bf16_t*)(a.ws + WS_K), (bf16_t*)(a.ws + WS_V), (const float*)(a.ws + WS_SSQKV)}; }

__global__ void __launch_bounds__(512, 2) fwd(Args a) {
    extern __shared__ __attribute__((aligned(16))) unsigned char lds_raw[];
    LAS unsigned char* lds = (LAS unsigned char*)lds_raw;
    const int G = gridDim.x, bx = blockIdx.x;
    const int vcu = (G % 8 == 0) ? (bx % 8) * (G / 8) + bx / 8 : bx;
    const int wave = __builtin_amdgcn_readfirstlane(threadIdx.x >> 6);
    volatile LAS unsigned* bst = (volatile LAS unsigned*)(lds + LDS_BYTES - 64);
    unsigned* barw = (unsigned*)(a.ws + WS_CTL) + 1024;
    const unsigned xcc = xb_xcc_id();
    if (wave == 0) { if (lane_id() == 0) { bst[0] = 0u; bst[1] = 0u; bst[3] = 0u; bst[5] = 0u; bst[8] = 0u; bst[9] = 0u; bst[6] = (G == 256 && a.ph_lo == 0 && a.ph_hi == 16) ? 1u : 0u; (void)xb_add(&barw[XB_XCNT(xcc)], 1u);
        (void)xb_add((unsigned*)(a.ws + WS_PBAR + ((bx & 7) >> 1) * 16384) + XB_XCNT(xcc), 1u);
        __hip_atomic_store((unsigned*)(a.ws + WS_OXCC) + bx, xcc + 1u, __ATOMIC_RELAXED, __HIP_MEMORY_SCOPE_AGENT); } }
    __syncthreads();
#if defined(PROBE_KIND) && PROBE_KIND == 7
#define GRID_SYNC() do { for (int rb_ = 0; rb_ < 1 + PROBE_N; ++rb_) xcd_barrier(barw, xcc, bst, (unsigned)G, wave); } while (0)
#else
#define GRID_SYNC() xcd_barrier(barw, xcc, bst, (unsigned)G, wave)
#endif
    int p0 = a.ph_lo;
    if (p0 == 0 && a.ph_hi > 0) {
        int lane = lane_id(); asm volatile("" : "+v"(lane));
        for (int rep_ = 0; rep_ < PROBE_REPS(PK_PRO, true); ++rep_) { prologue<0>(a, lds, vcu * 8 + wave, G * 8, lane, wave); __syncthreads(); }
        if (a.ph_hi == 1) { prologue<3>(a, lds, vcu * 8 + wave, G * 8, lane, wave); __syncthreads(); }
        p0 = 1;
    }
    const int p1 = a.ph_hi < 15 ? a.ph_hi : 15;
    const bool fuse_fin = (a.ph_hi == 16 && G == (T / BM) * (DM / BM));
    for (int p = p0; p < p1; ++p) {
        const bool oct_seam = FAST_GEMM && G == 256 && a.ph_lo == 0 && (p == 4 || p == 5 || p == 8 || p == 11 || p == 12);
        if (p > a.ph_lo) {
            if (oct_seam && __builtin_amdgcn_readfirstlane((int)bst[5]) != 0) octet_barrier((unsigned*)(a.ws + WS_OBAR) + (bx & 7) * 64, barw, bst, wave);
            else {
                const bool pair_ = FAST_GEMM && FAST_MLA && FAST_BAND && p >= 3 && __builtin_amdgcn_readfirstlane((int)bst[6]) != 0;
                unsigned* sb_ = pair_ ? (unsigned*)(a.ws + WS_PBAR + ((bx & 7) >> 1) * 16384) : barw;
                xcd_barrier(sb_, xcc, pair_ ? bst + 8 : bst, pair_ ? 64u : (unsigned)G, wave);
            } }
        if (p == 1 && a.ph_lo == 0 && G == 256) {
            if (wave == 0) { const int ln_ = lane_id(); bool ok_ = true;
                for (int j_ = 0; j_ < 4; ++j_) { const int b_ = ln_ + 64 * j_; const unsigned v_ = __hip_atomic_load((unsigned*)(a.ws + WS_OXCC) + b_, __ATOMIC_RELAXED, __HIP_MEMORY_SCOPE_AGENT), r_ = __hip_atomic_load((unsigned*)(a.ws + WS_OXCC) + (b_ & 7), __ATOMIC_RELAXED, __HIP_MEMORY_SCOPE_AGENT); ok_ = ok_ && (v_ == r_) && (v_ != 0u); }
                const bool all_ = __all(ok_);
                if (ln_ == 0) bst[5] = all_ ? 1u : 0u; }
            __syncthreads();
        }
#define WS_HERE(w) __attribute__((address_space(1))) unsigned char* w##_g = (__attribute__((address_space(1))) unsigned char*)a.ws; asm volatile("" : "+s"(w##_g)); unsigned char* w = (unsigned char*)w##_g
        const int kind = phase_kind(p), layer = phase_layer(p), li = layer >> 1;
        if (kind == PK_CQKV) {
#if FAST_GEMM
            for (int rep_ = 0; rep_ < PROBE_REPS(PK_CQKV, true); ++rep_) {
            if (G == 256) {
                int vcu_o = vcu; asm volatile("" : "+s"(vcu_o));
#define vcu vcu_o
                const int ox_ = vcu >> 5, oj_ = vcu & 31, ojj_ = oj_ - 16, opm_ = ox_ * 8 + ((oj_ & 15) >> 1);
                const bool otA_ = oj_ < 16;
                { WS_HERE(ws); const Gemm g{(const bf16_t*)(ws + WS_XB), (const bf16_t*)(ws + W_CIN) + (size_t)li * C_INP * DM + (size_t)1024 * DM, T, 512, DM, 0};
                  const ListOrder so{opm_ * 2 + (oj_ & 1), otA_ ? 1 : 0, 2};
                  gemm_phase<EpiCin, ListOrder, true, true>(lds, g, so, EpiCin{(bf16_t*)(ws + WS_CQ), (bf16_t*)(ws + WS_CKV), (bf16_t*)(ws + WS_KPE), (bf16_t*)(ws + WS_G), (const float*)(ws + WS_SSQ),
                      (float*)(ws + WS_SSQQ), (float*)(ws + WS_SSQKV), (const float*)(ws + WS_ROPE), 4, 0}, wave); }
                { WS_HERE(ws); const Gemm g{(const bf16_t*)(ws + WS_CQ), (const bf16_t*)(ws + W_CQB) + (size_t)li * 1536 * 256, T, 1536, 256, (int)(D_CQ * 2)};
                  const ListOrder so{otA_ ? opm_ * 6 + (oj_ & 1) : opm_ * 6 + 2 + (ojj_ & 1), otA_ ? 1 : 2, 6, 2};
                  gemm_phase<EpiQ, ListOrder, true, true>(lds, g, so, EpiQ{(bf16_t*)(ws + WS_Q), (const float*)(ws + WS_SSQQ), (const float*)(ws + WS_ROPE)}, wave); }
                { WS_HERE(ws); const Gemm g{(const bf16_t*)(ws + WS_CKV), (const bf16_t*)(ws + W_CKVB) + (size_t)li * 2048 * 128, T, 2048, 128, (int)(D_CKV * 2)};
                  const ListOrder so{otA_ ? 0 : opm_ * 8 + 4 * (ojj_ & 1), otA_ ? 0 : 4, 8};
                  gemm_phase<EpiKV, ListOrder, true, true>(lds, g, so, EpiKV{(bf16_t*)(ws + WS_K), (bf16_t*)(ws + WS_V), (const float*)(ws + WS_SSQKV)}, wave); }
#undef vcu
            } else {
            { WS_HERE(ws); const Gemm g{(const bf16_t*)(ws + WS_CQ), (const bf16_t*)(ws + W_CQB) + (size_t)li * 1536 * 256, T, 1536, 256, (int)(D_CQ * 2)}; StaticOrder so; so.init(T, 1536, G, bx);
              gemm_phase<EpiQ, StaticOrder, true, true>(lds, g, so, EpiQ{(bf16_t*)(ws + WS_Q), (const float*)(ws + WS_SSQQ), (const float*)(ws + WS_ROPE)}, wave); }
            { WS_HERE(ws); const Gemm g{(const bf16_t*)(ws + WS_CKV), (const bf16_t*)(ws + W_CKVB) + (size_t)li * 2048 * 128, T, 2048, 128, (int)(D_CKV * 2)}; StaticOrder so; so.init(T, 2048, G, bx);
              gemm_phase<EpiKV, StaticOrder, true, true>(lds, g, so, EpiKV{(bf16_t*)(ws + WS_K), (bf16_t*)(ws + WS_V), (const float*)(ws + WS_SSQKV)}, wave); }
            }
            }
#endif
        }
#if FAST_GEMM
        else if (kind == PK_ABIN) for (int rep_ = 0; rep_ < PROBE_REPS(PK_ABIN, true); ++rep_) { WS_HERE(ws);
            const bool split_tail = (p == 8 && G == 256);
            const int ncol = split_tail ? 12 * BM : AB_IN;
            const Gemm g{(const bf16_t*)(ws + WS_XB), (const bf16_t*)(ws + W_ABIN) + (size_t)li * AB_IN * DM, T, ncol, DM, 0}; StaticOrder so; so.init(T, ncol, G, bx);
            gemm_phase<EpiABin, StaticOrder, true, true>(lds, g, so, EpiABin{(bf16_t*)(ws + WS_QKV), (bf16_t*)(ws + WS_G), (const float*)(ws + WS_SSQ)}, wave);
            if (split_tail) { if ((vcu & 31) < 16) { WS_HERE(ws2);
                const int hpm = (vcu >> 5) * 8 + ((vcu & 31) >> 1), half = vcu & 1;
                const Gemm g2{(const bf16_t*)(ws2 + WS_XB), (const bf16_t*)(ws2 + W_ABIN) + (size_t)li * AB_IN * DM + (size_t)(12 * BM + half * 128) * DM, T, BM, DM, 0};
                const ListOrder so2{hpm, 1, 1};
                gemm_phase<EpiABinHalf, ListOrder, true, true, true>(lds, g2, so2, EpiABinHalf{(bf16_t*)(ws2 + WS_G), (const float*)(ws2 + WS_SSQ), half * 128, 0}, wave); } }
            if (rep_ == 0 && a.ph_lo == 0 && (p == 1 || (p == 8 && a.ph_hi > 8))) {
                const int nfull = (T / BM) * (AB_IN / BM) / G, rem = (T / BM) * (AB_IN / BM) - nfull * G;
                const bool some_idle = (rem > 0 && rem < G);
                if (!some_idle || bx >= rem) {
                    int lane = lane_id(); asm volatile("" : "+v"(lane));
                    const int cgw = some_idle ? (bx - rem) * 8 + wave : vcu * 8 + wave, cn = some_idle ? (G - rem) * 8 : G * 8;
                    if (p == 1) prologue<3>(a, lds, cgw, cn, lane, wave);
                }
                __syncthreads();
            } }
        else if (kind == PK_OUT && p == 14 && fuse_fin) { WS_HERE(ws); const Gemm g{(const bf16_t*)(ws + WS_G), (const bf16_t*)(ws + W_COUT) + (size_t)li * DM * DM, T, DM, DM, 0}; StaticOrder so; so.init(T, DM, G, bx);
            gemm_phase<EpiOutFin, StaticOrder, true, true>(lds, g, so, EpiOutFin{(const bf16_t*)(ws + WS_XB), (const unsigned char*)a.out, a.out, (float*)(ws + WS_SSQ), (unsigned*)(ws + WS_FCNT), a.final_norm}, wave); }
        else if (kind == PK_OUT) for (int rep_ = 0; rep_ < PROBE_REPS(PK_OUT, layer == 0); ++rep_) { WS_HERE(ws); const Gemm g{(const bf16_t*)(ws + WS_G), (const bf16_t*)(ws + ((layer & 1) ? W_COUT : W_ABOUT)) + (size_t)li * DM * DM, T, DM, DM, 0}; StaticOrder so; so.init(T, DM, G, bx);
            gemm_phase<EpiOut, StaticOrder, true, true>(lds, g, so, EpiOut{(bf16_t*)(ws + WS_XB), (unsigned char*)a.out, (float*)(ws + WS_SSQ)}, wave); }
        else if (kind == PK_CIN) for (int rep_ = 0; rep_ < PROBE_REPS(PK_CIN, true); ++rep_) { WS_HERE(ws);
            const int ncin = (G == 256) ? 1024 : C_INP;
            const Gemm g{(const bf16_t*)(ws + WS_XB), (const bf16_t*)(ws + W_CIN) + (size_t)li * C_INP * DM, T, ncin, DM, 0}; StaticOrder so; so.init(T, ncin, G, bx);
            gemm_phase<EpiCin, StaticOrder, true, true>(lds, g, so, EpiCin{(bf16_t*)(ws + WS_CQ), (bf16_t*)(ws + WS_CKV), (bf16_t*)(ws + WS_KPE), (bf16_t*)(ws + WS_G), (const float*)(ws + WS_SSQ),
                  (float*)(ws + WS_SSQQ), (float*)(ws + WS_SSQKV), (const float*)(ws + WS_ROPE), 0, 0}, wave); }
#endif
#if FAST_MLA
        else if (kind == PK_CATT) { WS_HERE(ws);
            PROBE_DRY_REPS(PK_CATT, (mla2::phase<true>((char*)lds_raw, (const bf16_t*)(ws + WS_Q), (const bf16_t*)(ws + WS_K), (const bf16_t*)(ws + WS_KPE), (const bf16_t*)(ws + WS_V), (bf16_t*)(ws + WS_G), vcu, G, wave)));
            mla2::phase<false>((char*)lds_raw, (const bf16_t*)(ws + WS_Q), (const bf16_t*)(ws + WS_K), (const bf16_t*)(ws + WS_KPE), (const bf16_t*)(ws + WS_V), (bf16_t*)(ws + WS_G), vcu, G, wave); }
#endif
#if FAST_BAND
        else if (kind == PK_ABATT) { WS_HERE(ws); int lane = lane_id(); asm volatile("" : "+v"(lane));
            PROBE_DRY_REPS(PK_ABATT, (band::phase<true>(lds, (const bf16_t*)(ws + WS_QKV), (bf16_t*)(ws + WS_G), (bf16_t*)(ws + WS_OC), (float*)(ws + WS_LSE), (const float*)(ws + WS_BT), a.ab_sinks + li * 8, vcu, G, wave, lane)));
            band::phase<false>(lds, (const bf16_t*)(ws + WS_QKV), (bf16_t*)(ws + WS_G), (bf16_t*)(ws + WS_OC), (float*)(ws + WS_LSE), (const float*)(ws + WS_BT), a.ab_sinks + li * 8, vcu, G, wave, lane); }
#endif
    }
    if (a.ph_hi == 16 && !(fuse_fin && a.ph_lo <= 14)) {
        if (15 > a.ph_lo) GRID_SYNC();
        int lane = lane_id(); asm volatile("" : "+v"(lane));
        final_norm_phase(a, vcu * 8 + wave, G * 8, lane);
    }
}

extern "C" void kernel_launch(void* const* d_in, const int* in_sizes, int n_in, void* d_out, int out_size, void* d_ws, size_t ws_size, hipStream_t stream) {
    static int grid = 0;
    if (grid == 0) {
        if (n_in != 14 || in_sizes[0] != T * DM || out_size != T * DM || ws_size < WS_END) {
            fprintf(stderr, "kernel_launch: unexpected shapes: n_in %d in0 %d out %d ws %zu (need >= %zu)\n", n_in, n_in > 0 ? in_sizes[0] : -1, out_size, ws_size, (size_t)WS_END);
            grid = -1; return; }
        int dev = 0, cus = 0, per_cu = 0;
        hipGetDevice(&dev); hipDeviceGetAttribute(&cus, hipDeviceAttributeMultiprocessorCount, dev);
        if (hipFuncSetAttribute((const void*)fwd, hipFuncAttributeMaxDynamicSharedMemorySize, LDS_BYTES) != hipSuccess) { fprintf(stderr, "kernel_launch: hipFuncSetAttribute failed\n"); grid = -1; return; }
        hipOccupancyMaxActiveBlocksPerMultiprocessor(&per_cu, (const void*)fwd, 512, LDS_BYTES);
        if (per_cu < 1) { fprintf(stderr, "kernel_launch: occupancy query says %d blocks per CU\n", per_cu); per_cu = 1; }
        (void)hipGetLastError();
        grid = cus;
        if (grid * 8 < (T / BM) * (AB_IN / BM)) { fprintf(stderr, "kernel_launch: %d CUs: more than 8 GEMM units per workgroup (row-scale table)\n", cus); grid = -1; return; }
    }
    if (grid < 0) return;
    Args a{};
    a.x = (const float*)d_in[0]; a.pos = (const int*)d_in[1]; a.norm_w = (const float*)d_in[2]; a.rel_bias = (const float*)d_in[3];
    a.ab_w_in = (const float*)d_in[4]; a.ab_sinks = (const float*)d_in[5]; a.ab_w_out = (const float*)d_in[6]; a.c_w_in = (const float*)d_in[7];
    a.c_q_norm = (const float*)d_in[8]; a.c_w_qb = (const float*)d_in[9]; a.c_kv_norm = (const float*)d_in[10]; a.c_w_kvb = (const float*)d_in[11];
    a.c_w_out = (const float*)d_in[12]; a.final_norm = (const float*)d_in[13];
    a.out = (float*)d_out; a.ws = (unsigned char*)d_ws;
    unsigned char* ws = (unsigned char*)d_ws;
    int lo = -1;
    auto flush = [&](int hi) {
        if (lo >= 0 && hi > lo) {
            a.ph_lo = lo; a.ph_hi = hi;
            (void)hipMemsetAsync((unsigned char*)d_ws + WS_CTL, 0, 131072, stream);
            hipLaunchKernelGGL(fwd, dim3(grid), dim3(512), LDS_BYTES, stream, a);
            hipError_t e = hipPeekAtLastError();
            if (e != hipSuccess) fprintf(stderr, "kernel_launch: launch of phases [%d,%d) failed: %s\n", lo, hi, hipGetErrorString(e));
        }
        lo = -1;
    };
    for (int p = 0; p < N_PHASES; ++p) {
        const int kind = phase_kind(p), li = phase_layer(p) >> 1;
        bool in_fwd = true;
        const bool gemm_kind = (kind == PK_ABIN || kind == PK_OUT || kind == PK_CIN || kind == PK_CQKV);
        if (!FAST_GEMM && gemm_kind) {
            flush(p);
            if (kind == PK_ABIN) hipLaunchKernelGGL(naive_gemm_k<EpiABin>, dim3(2048), dim3(256), 0, stream, make_gemm(a, p, 0), make_epi_abin(a));
            else if (kind == PK_OUT) hipLaunchKernelGGL(naive_gemm_k<EpiOut>, dim3(2048), dim3(256), 0, stream, make_gemm(a, p, 0), make_epi_out(a, p));
            else if (kind == PK_CIN) hipLaunchKernelGGL(naive_gemm_k<EpiCin>, dim3(2048), dim3(256), 0, stream, make_gemm(a, p, 0), make_epi_cin(a));
            else { hipLaunchKernelGGL(naive_gemm_k<EpiQ>, dim3(2048), dim3(256), 0, stream, make_gemm(a, p, 0), make_epi_q(a));
                   hipLaunchKernelGGL(naive_gemm_k<EpiKV>, dim3(2048), dim3(256), 0, stream, make_gemm(a, p, 1), make_epi_kv(a)); }
            in_fwd = (kind == PK_CQKV);
        } else if (kind == PK_ABATT && !FAST_BAND) {
            flush(p);
            hipLaunchKernelGGL(naive_ab_attn, dim3(1024), dim3(256), 0, stream, (const bf16_t*)(ws + WS_QKV), (bf16_t*)(ws + WS_G), (const float*)(ws + WS_BT), a.ab_sinks + li * 8);
            in_fwd = false;
        } else if (kind == PK_CATT && !FAST_MLA) {
            flush(p);
            hipLaunchKernelGGL(naive_mla_attn, dim3(1024), dim3(256), 0, stream, (const bf16_t*)(ws + WS_Q), (const bf16_t*)(ws + WS_K), (const bf16_t*)(ws + WS_KPE), (const bf16_t*)(ws + WS_V), (bf16_t*)(ws + WS_G));
            in_fwd = false;
        }
        if (in_fwd && lo < 0) lo = p;
        if (!in_fwd) lo = -1;
    }
    flush(N_PHASES);
}
```
